# Optimizing an MI355X kernel written in HIP

```python
import jax, jax.numpy as jnp
from jax import lax
import numpy as np

D_MODEL = 1024
BATCH = 8
SEQ = 2048
DEPTH = 4
DEC_BATCH = 8
DEC_SEQ = 32
PAST_LEN = 4096

CHUNK = 64
Q_BLOCK = 128
MLA_HEADS = 8
MLA_D_NOPE = 64
MLA_D_ROPE = 32
MLA_D_V = 64
MLA_Q_RANK = 256
MLA_KV_RANK = 256
MLA_SCALE = (MLA_D_NOPE + MLA_D_ROPE) ** -0.5
ROPE_THETA = 10000.0
MASK_VALUE = -1e30
HG_HEADS = 4
HG_DK = 128
HG_DV = 128
LB_TINY = 1e-30
CM_CHUNK = 128
CM_GROUPS = 4
CM_WIDTH = 512
CM_GROUP_DIM = CM_WIDTH // CM_GROUPS
D_FF = -(-8 * D_MODEL // (3 * 256)) * 256
ALPHA = (2 * DEPTH) ** 0.25
BETA = (8 * DEPTH) ** -0.25
EPS = 1e-5

SPLIT_SIZES = (MLA_Q_RANK, MLA_KV_RANK, MLA_D_ROPE,
               HG_HEADS * HG_DK, HG_HEADS * HG_DK, HG_HEADS * HG_DV, HG_HEADS * HG_DV,
               CM_WIDTH, CM_WIDTH, D_MODEL, D_MODEL, D_MODEL)
D_IN = sum(SPLIT_SIZES)

kernel_name = "hybrid_mla_hgrn2_chunkmlp_stream_step"


def layer_norm(x, g, b):
    xf = x.astype(jnp.float32)
    mu = jnp.mean(xf, -1, keepdims=True)
    var = jnp.mean(jnp.square(xf - mu), -1, keepdims=True)
    return ((xf - mu) * lax.rsqrt(var + EPS) * g + b).astype(x.dtype)


def rms_norm(x, g):
    xf = x.astype(jnp.float32)
    return (xf * lax.rsqrt(jnp.mean(xf * xf, -1, keepdims=True) + EPS) * g).astype(x.dtype)


def rope(x, pos):
    half = x.shape[-1] // 2
    inv = 1.0 / (ROPE_THETA ** (jnp.arange(half, dtype=jnp.float32) / half))
    ang = pos.astype(jnp.float32)[:, None] * inv[None]
    cos = jnp.cos(ang)[None, :, None]
    sin = jnp.sin(ang)[None, :, None]
    xf = x.astype(jnp.float32)
    x1, x2 = xf[..., :half], xf[..., half:]
    return jnp.concatenate([x1 * cos - x2 * sin, x2 * cos + x1 * sin], -1).astype(x.dtype)


def mla_attend(q_lat, q_rope, ckv, krope, q_pos, k_pos):
    s = jnp.einsum('bqhr,bkr->bhqk', q_lat, ckv) + jnp.einsum('bqhd,bkd->bhqk', q_rope, krope)
    s = s.astype(jnp.float32) * MLA_SCALE
    mask = (k_pos[None, :] // CHUNK) <= (q_pos[:, None] // CHUNK)
    s = jnp.where(mask[None, None], s, MASK_VALUE)
    p = jax.nn.softmax(s, axis=-1).astype(ckv.dtype)
    return jnp.einsum('bhqk,bkr->bqhr', p, ckv)


def mla_prompt(q_lat, q_rope, ckv, krope, pos):
    B, S = q_lat.shape[:2]
    nb = S // Q_BLOCK
    ql = q_lat.reshape(B, nb, Q_BLOCK, MLA_HEADS, MLA_KV_RANK).swapaxes(0, 1)
    qr = q_rope.reshape(B, nb, Q_BLOCK, MLA_HEADS, MLA_D_ROPE).swapaxes(0, 1)
    qp = pos.reshape(nb, Q_BLOCK)
    o = lax.map(lambda a: mla_attend(a[0], a[1], ckv, krope, a[2], pos), (ql, qr, qp))
    return o.swapaxes(0, 1).reshape(B, S, MLA_HEADS, MLA_KV_RANK)


def hgrn_chunk(S0, q, k, v, logf):
    L = q.shape[1]
    b = jnp.cumsum(logf, axis=1)
    causal = jnp.tril(jnp.ones((L, L), dtype=bool))[None, :, :, None, None]
    diff = b[:, :, None] - b[:, None, :]
    decay = jnp.where(causal, jnp.exp(jnp.where(causal, diff, 0.0)), 0.0)
    A = jnp.einsum('bthk,btshk->btsh', q, decay * k[:, None])
    o = jnp.einsum('btsh,bshv->bthv', A, v) + jnp.einsum('bthk,bhkv->bthv', q * jnp.exp(b), S0)
    bL = b[:, -1]
    S_new = jnp.exp(bL)[..., None] * S0 + jnp.einsum('bshk,bshv->bhkv', k * jnp.exp(bL[:, None] - b), v)
    return S_new, o


def hgrn_prompt(q, k, v, logf):
    B, S = q.shape[:2]
    n = S // CHUNK
    to_c = lambda t: t.reshape(B, n, CHUNK, *t.shape[2:]).swapaxes(0, 1)
    S0 = jnp.zeros((B, HG_HEADS, HG_DK, HG_DV), jnp.float32)
    S_fin, o = lax.scan(lambda s, xs: hgrn_chunk(s, *xs), S0, (to_c(q), to_c(k), to_c(v), to_c(logf)))
    return S_fin, o.swapaxes(0, 1).reshape(B, S, HG_HEADS, HG_DV)


def chunk_mlp(u, v, w_s, b_s):
    B, S, _ = v.shape
    L = min(S, CM_CHUNK)
    n = S // L
    tri = jnp.tril(w_s[:, :L, :L])
    vc = v.reshape(B, n, L, CM_GROUPS, CM_GROUP_DIM)
    s = jnp.einsum('gij,bnjgc->bnigc', tri, vc) + b_s[:, :L].T[None, None, :, :, None]
    return u * s.reshape(B, S, CM_WIDTH)


def trunk_layer(x, pos, lw, lb, past):
    B, S, _ = x.shape
    idx = np.cumsum(SPLIT_SIZES)[:-1].tolist()
    cq, ckv_raw, kr_raw, hq, hf, hi, hg, cu, cv, ga, gb, gc = jnp.split(x @ lw['w_in'], idx, axis=-1)

    cq = rms_norm(cq, lw['q_norm_g'])
    q = (cq @ lw['w_uq']).reshape(B, S, MLA_HEADS, MLA_D_NOPE + MLA_D_ROPE)
    q_rope = rope(q[..., MLA_D_NOPE:], pos)
    q_lat = jnp.einsum('bshn,rhn->bshr', q[..., :MLA_D_NOPE], lw['w_uk'])
    ckv = rms_norm(ckv_raw, lw['kv_norm_g'])
    krope = rope(kr_raw[:, :, None], pos)[:, :, 0]

    lbh = lb.reshape(HG_HEADS, HG_DK)
    zf = hf.astype(jnp.float32).reshape(B, S, HG_HEADS, HG_DK)
    logf = jnp.logaddexp(jnp.log(lbh + LB_TINY), jnp.log1p(-lbh) + jax.nn.log_sigmoid(zf))
    kk = (1.0 - lbh) * jax.nn.sigmoid(-zf)
    qq = hq.astype(jnp.float32).reshape(B, S, HG_HEADS, HG_DK)
    vv = hi.astype(jnp.float32).reshape(B, S, HG_HEADS, HG_DV)

    if past is None:
        o_lat = mla_prompt(q_lat, q_rope, ckv, krope, pos)
        S_fin, o_h = hgrn_prompt(qq, kk, vv, logf)
    else:
        ckv_p, kr_p, S0 = past
        k_pos = jnp.concatenate([jnp.arange(ckv_p.shape[1], dtype=jnp.int32), pos])
        o_lat = mla_attend(q_lat, q_rope, jnp.concatenate([ckv_p, ckv], 1),
                           jnp.concatenate([kr_p, krope], 1), pos, k_pos)
        S_fin, o_h = hgrn_chunk(S0.astype(jnp.float32), qq, kk, vv, logf)

    y_a = jnp.einsum('bshr,rhv->bshv', o_lat, lw['w_uv']).reshape(B, S, MLA_HEADS * MLA_D_V) @ lw['w_pa']
    o_h = rms_norm(o_h, lw['hg_norm_g']).reshape(B, S, HG_HEADS * HG_DV)
    y_b = (o_h * jax.nn.silu(hg.astype(jnp.float32))).astype(x.dtype) @ lw['w_pb']

    u = jax.nn.gelu(cu, approximate=False)
    v_cm = layer_norm(jax.nn.gelu(cv, approximate=False), lw['cm_ln_g'], lw['cm_ln_b'])
    y_c = chunk_mlp(u, v_cm, lw['cm_ws'], lw['cm_bs']) @ lw['w_pc']

    m = jax.nn.sigmoid(ga) * y_a + jax.nn.sigmoid(gb) * y_b + jax.nn.sigmoid(gc) * y_c
    x = layer_norm(ALPHA * x + m @ lw['w_o'], lw['ln1_g'], lw['ln1_b'])

    gate, up = jnp.split(x @ lw['w_up'], 2, axis=-1)
    x = layer_norm(ALPHA * x + (jax.nn.silu(gate) * up) @ lw['w_down'], lw['ln2_g'], lw['ln2_b'])
    return x, (ckv, krope, S_fin.astype(x.dtype), v_cm)


def setup_inputs(seed: int = 0) -> dict:
    key = jax.random.key(seed)
    ks = jax.random.split(key, 32)
    f32 = jnp.float32
    nrm = lambda k, shape, scale: jax.random.normal(k, shape, f32) * scale
    gain = lambda k, shape: 1.0 + 0.02 * jax.random.normal(k, shape, f32)
    bias = lambda k, shape: 0.02 * jax.random.normal(k, shape, f32)
    L = DEPTH
    return {
        "x_prompt": nrm(ks[0], (BATCH, SEQ, D_MODEL), 1.0),
        "x_sample": nrm(ks[1], (DEC_BATCH, DEC_SEQ, D_MODEL), 1.0),
        "cache_mla_ckv": nrm(ks[2], (L, DEC_BATCH, PAST_LEN, MLA_KV_RANK), 1.0),
        "cache_mla_krope": nrm(ks[3], (L, DEC_BATCH, PAST_LEN, MLA_D_ROPE), 1.0),
        "state_hgrn": nrm(ks[4], (L, DEC_BATCH, HG_HEADS, HG_DK, HG_DV), 0.5),
        "emb_ln_g": gain(ks[5], (D_MODEL,)),
        "emb_ln_b": bias(ks[6], (D_MODEL,)),
        "w_in": nrm(ks[7], (L, D_MODEL, D_IN), D_MODEL ** -0.5),
        "q_norm_g": gain(ks[8], (L, MLA_Q_RANK)),
        "w_uq": nrm(ks[9], (L, MLA_Q_RANK, MLA_HEADS * (MLA_D_NOPE + MLA_D_ROPE)), MLA_Q_RANK ** -0.5),
        "w_uk": nrm(ks[10], (L, MLA_KV_RANK, MLA_HEADS, MLA_D_NOPE), MLA_KV_RANK ** -0.5),
        "kv_norm_g": gain(ks[11], (L, MLA_KV_RANK)),
        "w_uv": nrm(ks[12], (L, MLA_KV_RANK, MLA_HEADS, MLA_D_V), MLA_KV_RANK ** -0.5),
        "hg_lb": nrm(ks[13], (L, HG_HEADS * HG_DK), 1.0),
        "hg_norm_g": gain(ks[14], (L, HG_HEADS, HG_DV)),
        "cm_ln_g": gain(ks[15], (L, CM_WIDTH)),
        "cm_ln_b": bias(ks[16], (L, CM_WIDTH)),
        "cm_ws": nrm(ks[17], (L, CM_GROUPS, CM_CHUNK, CM_CHUNK), CM_CHUNK ** -0.5),
        "cm_bs": gain(ks[18], (L, CM_GROUPS, CM_CHUNK)),
        "w_pa": nrm(ks[19], (L, MLA_HEADS * MLA_D_V, D_MODEL), (MLA_HEADS * MLA_D_V) ** -0.5 * BETA),
        "w_pb": nrm(ks[20], (L, HG_HEADS * HG_DV, D_MODEL), (HG_HEADS * HG_DV) ** -0.5 * BETA),
        "w_pc": nrm(ks[21], (L, CM_WIDTH, D_MODEL), CM_WIDTH ** -0.5 * BETA),
        "w_o": nrm(ks[22], (L, D_MODEL, D_MODEL), D_MODEL ** -0.5 * BETA),
        "ln1_g": gain(ks[23], (L, D_MODEL)),
        "ln1_b": bias(ks[24], (L, D_MODEL)),
        "w_up": nrm(ks[25], (L, D_MODEL, 2 * D_FF), D_MODEL ** -0.5),
        "w_down": nrm(ks[26], (L, D_FF, D_MODEL), D_FF ** -0.5 * BETA),
        "ln2_g": gain(ks[27], (L, D_MODEL)),
        "ln2_b": bias(ks[28], (L, D_MODEL)),
    }


def reference(x_prompt, x_sample, cache_mla_ckv, cache_mla_krope, state_hgrn, emb_ln_g, emb_ln_b,
              w_in, q_norm_g, w_uq, w_uk, kv_norm_g, w_uv, hg_lb, hg_norm_g, cm_ln_g, cm_ln_b,
              cm_ws, cm_bs, w_pa, w_pb, w_pc, w_o, ln1_g, ln1_b, w_up, w_down, ln2_g, ln2_b):
    sm = jax.nn.softmax(hg_lb.astype(jnp.float32), axis=0)
    lb_all = jnp.concatenate([jnp.zeros_like(sm[:1]), jnp.cumsum(sm[1:], axis=0)], axis=0)

    pos_p = jnp.arange(x_prompt.shape[1], dtype=jnp.int32)
    pos_s = cache_mla_ckv.shape[2] + jnp.arange(x_sample.shape[1], dtype=jnp.int32)

    xp = layer_norm(x_prompt, emb_ln_g, emb_ln_b)
    xs = layer_norm(x_sample, emb_ln_g, emb_ln_b)
    ckv_p_l, kr_p_l, s_p_l, ckv_s_l, kr_s_l, s_s_l, v_s_l = [], [], [], [], [], [], []
    for l in range(DEPTH):
        lw = dict(w_in=w_in[l], q_norm_g=q_norm_g[l], w_uq=w_uq[l], w_uk=w_uk[l], kv_norm_g=kv_norm_g[l],
                  w_uv=w_uv[l], hg_norm_g=hg_norm_g[l], cm_ln_g=cm_ln_g[l], cm_ln_b=cm_ln_b[l],
                  cm_ws=cm_ws[l], cm_bs=cm_bs[l], w_pa=w_pa[l], w_pb=w_pb[l], w_pc=w_pc[l], w_o=w_o[l],
                  ln1_g=ln1_g[l], ln1_b=ln1_b[l], w_up=w_up[l], w_down=w_down[l],
                  ln2_g=ln2_g[l], ln2_b=ln2_b[l])
        xp, (ckv_p, kr_p, s_p, _) = trunk_layer(xp, pos_p, lw, lb_all[l], None)
        xs, (ckv_s, kr_s, s_s, v_s) = trunk_layer(
            xs, pos_s, lw, lb_all[l], (cache_mla_ckv[l], cache_mla_krope[l], state_hgrn[l]))
        ckv_p_l.append(ckv_p); kr_p_l.append(kr_p); s_p_l.append(s_p)
        ckv_s_l.append(ckv_s); kr_s_l.append(kr_s); s_s_l.append(s_s); v_s_l.append(v_s)

    return (xp, xs, jnp.stack(ckv_p_l), jnp.stack(kr_p_l), jnp.stack(s_p_l),
            jnp.stack(ckv_s_l), jnp.stack(kr_s_l), jnp.stack(s_s_l), jnp.stack(v_s_l))
```

```cpp
#include <hip/hip_runtime.h>
#include <hip/hip_cooperative_groups.h>
#include <stdint.h>
#include <stdio.h>
namespace cg = cooperative_groups;

#ifndef ONE_LAUNCH
#define ONE_LAUNCH 1
#endif

typedef unsigned short bf16_t;
typedef short bf16x8 __attribute__((ext_vector_type(8)));
typedef float f32x4 __attribute__((ext_vector_type(4)));
typedef float f32x2 __attribute__((ext_vector_type(2)));
#define LAS __attribute__((address_space(3)))

constexpr int DM = 1024, TP = 16384, TS = 256, TT = TP + TS, DEPTH = 4, NZ = 6912;
constexpr int SEQ = 2048, DSEQ = 32, PAST = 4096, KSS = 4160;
constexpr int DFF = 2816;
constexpr int ZCQ = 0, ZCKV = 256, ZHQ = 512, ZHF = 1024, ZHI = 1536, ZHG = 2048, ZCU = 2560, ZCV = 3072, ZGA = 3584, ZGB = 4608, ZGC = 5632, ZKR = 6656;
constexpr float EPS = 1e-5f;
constexpr float ALPHA = 1.681792830507429f;
constexpr float QSCALE = 0.10206207261596577f * 1.4426950408889634f;
constexpr size_t O_YP = 0, O_YS = 16777216, O_CKVP = 17039360, O_KRP = 33816576, O_HSP = 35913728, O_CKVS = 38010880, O_KRS = 38273024, O_HSS = 38305792, O_VS = 40402944;
constexpr size_t W_IN = 0, W_UQ = W_IN + (size_t)NZ * 1024, W_UKV = W_UQ + 768 * 256, W_CAT = W_UKV + 1024 * 256, W_O = W_CAT + 1024 * 1536, W_UP = W_O + 1024 * 1024,
                 W_DN = W_UP + (size_t)5632 * 1024, W_END = W_DN + (size_t)1024 * DFF;
constexpr size_t al(size_t x) { return (x + 255) & ~(size_t)255; }
constexpr size_t WS_CTL = 0, WS_BAR = 4096, WS_ROPE = 32768, WS_LB = al(WS_ROPE + 2080 * 16 * 8), WS_WT = al(WS_LB + 4 * 512 * 4), WS_XB = al(WS_WT + W_END * 2),
                 WS_Z = al(WS_XB + (size_t)TT * 1024 * 2), WS_Q = al(WS_Z + (size_t)TT * NZ * 2), WS_KN = al(WS_Q + (size_t)TT * 768 * 2), WS_VT = al(WS_KN + (size_t)TP * 512 * 2),
                 WS_KRB = al(WS_VT + (size_t)TP * 512 * 2), WS_KNS = al(WS_KRB + (size_t)TP * 32 * 2), WS_VTS = al(WS_KNS + (size_t)8 * KSS * 512 * 2),
                 WS_KRS = al(WS_VTS + (size_t)8 * 512 * KSS * 2), WS_OCAT = al(WS_KRS + (size_t)8 * KSS * 32 * 2), WS_HS = al(WS_OCAT + (size_t)TT * 1536 * 2),
                 WS_HD = al(WS_HS + (size_t)1056 * 16384 * 2), WS_ST = al(WS_HD + (size_t)1056 * 128 * 4), WS_CKVN = al(WS_ST + (size_t)TT * 2 * 4), WS_END = al(WS_CKVN + (size_t)TT * 256 * 2);
constexpr int LDS_BYTES = 144 * 1024;

struct Params { const float* in[29]; float* out; unsigned char* ws; int ph_lo, ph_hi; };

typedef unsigned nt_u4 __attribute__((ext_vector_type(4)));
__device__ __forceinline__ void stnt4(void* p, uint4 v) { const nt_u4 t = {v.x, v.y, v.z, v.w}; __builtin_nontemporal_store(t, (nt_u4*)p); }
__device__ __forceinline__ float bf2f(bf16_t b) { return __uint_as_float(((unsigned)b) << 16); }
typedef __bf16 bf16x2_t __attribute__((ext_vector_type(2)));
__device__ __forceinline__ unsigned pk2(float lo, float hi) { f32x2 v = {lo, hi}; bf16x2_t b = __builtin_convertvector(v, bf16x2_t); return __builtin_bit_cast(unsigned, b); }
__device__ __forceinline__ bf16_t f2bf(float f) { return (bf16_t)(pk2(f, 0.f) & 0xffffu); }
__device__ __forceinline__ float lo16(unsigned u) { return __uint_as_float(u << 16); }
__device__ __forceinline__ float hi16(unsigned u) { return __uint_as_float(u & 0xffff0000u); }
__device__ __forceinline__ int opaque_tid() { int t = threadIdx.x; asm volatile("" : "+v"(t)); return t; }
template <int CTRL> __device__ __forceinline__ float dpp_f(float v) { return __int_as_float(__builtin_amdgcn_update_dpp(0, __float_as_int(v), CTRL, 0xF, 0xF, true)); }
__device__ __forceinline__ float row16_sum(float v) { v += dpp_f<0xB1>(v); v += dpp_f<0x4E>(v); v += dpp_f<0x141>(v); v += dpp_f<0x140>(v); return v; }
__device__ __forceinline__ float rl_f(float v, int lane) { return __int_as_float(__builtin_amdgcn_readlane(__float_as_int(v), lane)); }
__device__ __forceinline__ float wave_sum(float v) { v = row16_sum(v); return (rl_f(v, 0) + rl_f(v, 16)) + (rl_f(v, 32) + rl_f(v, 48)); }
__device__ __forceinline__ float xr16_max(float x) { const auto r = __builtin_amdgcn_permlane16_swap(__float_as_uint(x), __float_as_uint(x), false, false); return fmaxf(__uint_as_float(r[0]), __uint_as_float(r[1])); }
__device__ __forceinline__ float xr32_max(float x) { const auto r = __builtin_amdgcn_permlane32_swap(__float_as_uint(x), __float_as_uint(x), false, false); return fmaxf(__uint_as_float(r[0]), __uint_as_float(r[1])); }
__device__ __forceinline__ float xr16_sum(float x) { const auto r = __builtin_amdgcn_permlane16_swap(__float_as_uint(x), __float_as_uint(x), false, false); return __uint_as_float(r[0]) + __uint_as_float(r[1]); }
__device__ __forceinline__ float xr32_sum(float x) { const auto r = __builtin_amdgcn_permlane32_swap(__float_as_uint(x), __float_as_uint(x), false, false); return __uint_as_float(r[0]) + __uint_as_float(r[1]); }
__device__ __forceinline__ float sigmoidf_(float x) { return __builtin_amdgcn_rcpf(1.0f + __builtin_amdgcn_exp2f(-1.4426950408889634f * x)); }
__device__ __forceinline__ float gelu_exact(float v) {
    const float av = fabsf(v), t = __builtin_amdgcn_rcpf(av * 0.2316418882f + 1.0f);
    float q = t * 0.5307027145f + (-0.7265760135f); q = q * t + 0.7107068705f; q = q * t + (-0.142248368f); q = q * t + 0.127414796f; q = q * t;
    const float e = __builtin_amdgcn_exp2f((v * v) * (-0.72134752044f));
    const float m = v * (q * e); return v < 0.f ? m : v - m;
}
__device__ __forceinline__ f32x4 mfma16(bf16x8 a, bf16x8 b, f32x4 c) { return __builtin_amdgcn_mfma_f32_16x16x32_bf16(a, b, c, 0, 0, 0); }

namespace pg8 {
constexpr int BM = 256, BK = 64, HALF = 128, HTB = HALF * BK * 2, STAGE_BYTES = 8 * HTB, NXCD = 8, WGM = 8;
__host__ __device__ __forceinline__ int lds_byte(int r, int c) { const int st = (r >> 4) * 2 + (c >> 5), rr = r & 15, cc = c & 31, ob = rr * 64 + cc * 2; return st * 1024 + (ob ^ (((ob >> 9) & 1) << 5)); }
__host__ __device__ __forceinline__ void stage_rc(int b, int& R, int& C) { const int st = b / 1024, sb = b % 1024, swz = sb ^ (((sb >> 9) & 1) << 5); R = (st >> 1) * 16 + swz / 64; C = (st & 1) * 32 + (swz % 64) / 2; }
__host__ __device__ __forceinline__ int perm32(int rho) { const int n = rho >> 4, i = rho & 15; return 8 * (i >> 2) + 4 * n + (i & 3); }
struct Unit { int pm, pn, g; long ao, bo; };
struct Gemm { const bf16_t* A; const bf16_t* Bt; int M, N, K, lda, ldb; };
struct StaticOrder {
    int nM, nN, nwg, G, c;
    __device__ void init(int M, int N, int G_, int c_) { nM = M / BM; nN = N / BM; nwg = nM * nN; G = G_; c = c_; }
    __device__ bool next(int i, Unit& u) const {
        const long L = (long)i * G + c; if (L >= nwg) return false;
        int wgid = (int)L; { const int q = nwg / NXCD, r = nwg % NXCD, xcd = wgid % NXCD, off = wgid / NXCD; wgid = (xcd < r ? xcd * (q + 1) : r * (q + 1) + (xcd - r) * q) + off; }
        const int nig = WGM * nN, gid = wgid / nig, fm = gid * WGM, gsz = (nM - fm) < WGM ? (nM - fm) : WGM;
        u.pm = fm + ((wgid % nig) % gsz); u.pn = (wgid % nig) / gsz; u.g = 0; u.ao = 0; u.bo = 0; return true;
    }
};

template <class Epi, class Order>
__device__ __forceinline__ void gemm_phase(LAS unsigned char* lds, const Gemm g, const Order& S, const Epi& E) {
    const int tid = opaque_tid(), wid = __builtin_amdgcn_readfirstlane(tid >> 6), lane = tid & 63, wr = wid >> 2, wc = wid & 3, fr = lane & 15, fq = lane >> 4;
    const int K = g.K, nt = K / BK;
    unsigned voffA[2], voffB[2];
#pragma unroll
    for (int i = 0; i < 2; ++i) { int R, C; stage_rc(tid * 16 + i * 8192, R, C); const int Rb = Epi::PERM ? ((R & ~31) + perm32(R & 31)) : R;
        voffA[i] = (unsigned)(R * g.lda + C) * 2u; voffB[i] = (unsigned)(Rb * g.ldb + C) * 2u; }
    const size_t kstep = (size_t)(BK * 2);
    const size_t hstepA = (size_t)HALF * g.lda * 2, hstepB = (size_t)HALF * g.ldb * 2;
    const size_t tstepA = 2 * hstepA, tstepB = 2 * hstepB;
    const unsigned ldsw = (unsigned)wid * 1024u;
    const int aoff = lds_byte(wr * 64 + fr, fq * 8), boff = lds_byte(wc * 32 + fr, fq * 8);
#define PG8_SA(b, h) (((b) * 2 + (h)) * HTB)
#define PG8_SB(b, h) ((4 + (b) * 2 + (h)) * HTB)
#define PG8_STAGE(bufoff, gbase, voff) do { _Pragma("unroll") for (int _i = 0; _i < 2; ++_i) \
        __builtin_amdgcn_global_load_lds((const unsigned*)((const char*)(gbase) + (voff)[_i]), (LAS unsigned*)(lds + (bufoff) + ldsw + _i * 8192), 16, 0, 0); } while (0)
#define PG8_LDA(dst, b, h) do { _Pragma("unroll") for (int m = 0; m < 4; ++m) _Pragma("unroll") for (int k = 0; k < 2; ++k) dst[m][k] = *(const LAS bf16x8*)(lds + PG8_SA(b, h) + aoff + m * 2048 + k * 1024); } while (0)
#define PG8_LDB(dst, b, h) do { _Pragma("unroll") for (int n = 0; n < 2; ++n) _Pragma("unroll") for (int k = 0; k < 2; ++k) dst[n][k] = *(const LAS bf16x8*)(lds + PG8_SB(b, h) + boff + n * 2048 + k * 1024); } while (0)
#define PG8_MMA(ai, bj, At, Bt) do { __builtin_amdgcn_s_setprio(1); _Pragma("unroll") for (int m = 0; m < 4; ++m) _Pragma("unroll") for (int n = 0; n < 2; ++n) _Pragma("unroll") for (int k = 0; k < 2; ++k) \
        acc[ai][bj][m][n] = __builtin_amdgcn_mfma_f32_16x16x32_bf16(Bt[n][k], At[m][k], acc[ai][bj][m][n], 0, 0, 0); __builtin_amdgcn_s_setprio(0); } while (0)
#define PG8_WAIT_V(n) asm volatile("s_waitcnt vmcnt(" #n ")" ::: "memory")
#define PG8_WAIT_L(n) asm volatile("s_waitcnt lgkmcnt(" #n ")" ::: "memory")
#define PG8_BAR __builtin_amdgcn_s_barrier()
#define PG8_SCHED __builtin_amdgcn_sched_barrier(0)
    Unit cur, nxt; int ui = 0;
    if (!S.next(0, cur)) return;
    f32x4 acc[2][2][4][2];
#pragma unroll
    for (int a = 0; a < 2; ++a)
#pragma unroll
        for (int b = 0; b < 2; ++b)
#pragma unroll
            for (int m = 0; m < 4; ++m)
#pragma unroll
                for (int n = 0; n < 2; ++n) acc[a][b][m][n] = (f32x4){0.f, 0.f, 0.f, 0.f};
    bf16x8 At[4][2], B0[2][2], B1[2][2];
    const char* cA = (const char*)g.A + (size_t)cur.pm * tstepA + cur.ao; const char* cB = (const char*)g.Bt + (size_t)cur.pn * tstepB + cur.bo;
    PG8_STAGE(PG8_SB(0, 0), cB, voffB); PG8_STAGE(PG8_SA(0, 0), cA, voffA); PG8_STAGE(PG8_SB(0, 1), cB + hstepB, voffB); PG8_STAGE(PG8_SA(0, 1), cA + hstepA, voffA);
    if (wr == 1) PG8_BAR;
    PG8_WAIT_V(4); PG8_BAR;
    PG8_STAGE(PG8_SB(1, 0), cB + kstep, voffB); PG8_STAGE(PG8_SA(1, 0), cA + kstep, voffA); PG8_STAGE(PG8_SB(1, 1), cB + hstepB + kstep, voffB);
    PG8_WAIT_V(6); PG8_BAR;
    for (;;) {
        const bool has_next = S.next(ui + 1, nxt);
        const char* nA = has_next ? (const char*)g.A + (size_t)nxt.pm * tstepA + nxt.ao : cA; const char* nB = has_next ? (const char*)g.Bt + (size_t)nxt.pn * tstepB + nxt.bo : cB;
        for (int t = 0; t < nt; t += 2) {
            const bool last = (t == nt - 2);
            const char* a1 = cA + (size_t)(t + 1) * kstep;
            const char* a2 = last ? nA : cA + (size_t)(t + 2) * kstep; const char* b2 = last ? nB : cB + (size_t)(t + 2) * kstep;
            const char* a3 = a2 + kstep; const char* b3 = b2 + kstep;
            if constexpr (Epi::HOOK) { if (t == 8 || t == 16) E.mid(acc, cur, t, wr, wc, fr, fq); }
            PG8_LDB(B0, 0, 0); PG8_SCHED; PG8_LDA(At, 0, 0); PG8_STAGE(PG8_SA(1, 1), a1 + hstepA, voffA);
            PG8_WAIT_L(8); PG8_BAR; PG8_WAIT_L(0); PG8_MMA(0, 0, At, B0); PG8_BAR; PG8_SCHED;
            PG8_LDB(B1, 0, 1); PG8_STAGE(PG8_SB(0, 0), b2, voffB);
            PG8_BAR; PG8_WAIT_L(0); PG8_MMA(0, 1, At, B1); PG8_BAR;
            PG8_LDA(At, 0, 1); PG8_STAGE(PG8_SA(0, 0), a2, voffA);
            PG8_BAR; PG8_WAIT_L(0); PG8_MMA(1, 0, At, B0); PG8_BAR; PG8_SCHED;
            PG8_STAGE(PG8_SB(0, 1), b2 + hstepB, voffB);
            PG8_WAIT_V(6); PG8_BAR; PG8_MMA(1, 1, At, B1); PG8_BAR;
            PG8_LDB(B0, 1, 0); PG8_SCHED; PG8_LDA(At, 1, 0); PG8_STAGE(PG8_SA(0, 1), a2 + hstepA, voffA);
            PG8_WAIT_L(8); PG8_BAR; PG8_WAIT_L(0); PG8_MMA(0, 0, At, B0); PG8_BAR; PG8_SCHED;
            PG8_LDB(B1, 1, 1); PG8_STAGE(PG8_SB(1, 0), b3, voffB);
            PG8_BAR; PG8_WAIT_L(0); PG8_MMA(0, 1, At, B1); PG8_BAR;
            PG8_LDA(At, 1, 1); PG8_STAGE(PG8_SA(1, 0), a3, voffA);
            PG8_BAR; PG8_WAIT_L(0); PG8_MMA(1, 0, At, B0); PG8_BAR; PG8_SCHED;
            PG8_STAGE(PG8_SB(1, 1), b3 + hstepB, voffB);
            PG8_WAIT_V(6); PG8_BAR; PG8_MMA(1, 1, At, B1); PG8_BAR;
        }
        E(acc, cur, wr, wc, fr, fq);
        if (!has_next) break;
#pragma unroll
        for (int a = 0; a < 2; ++a)
#pragma unroll
            for (int b = 0; b < 2; ++b)
#pragma unroll
                for (int m = 0; m < 4; ++m)
#pragma unroll
                    for (int n = 0; n < 2; ++n) acc[a][b][m][n] = (f32x4){0.f, 0.f, 0.f, 0.f};
        cur = nxt; cA = nA; cB = nB; ++ui;
    }
    PG8_WAIT_V(0);
    if (wr == 0) PG8_BAR;
    PG8_BAR;
#undef PG8_SA
#undef PG8_SB
#undef PG8_STAGE
#undef PG8_LDA
#undef PG8_LDB
#undef PG8_MMA
#undef PG8_WAIT_V
#undef PG8_WAIT_L
#undef PG8_BAR
#undef PG8_SCHED
}
}
using pg8::Unit;

#define EPI_LOOP_ROWS _Pragma("unroll") for (int ai = 0; ai < 2; ++ai) _Pragma("unroll") for (int m = 0; m < 4; ++m)
__device__ __forceinline__ uint4 pack8(f32x4 a, f32x4 b) { uint4 o; o.x = pk2(a[0], a[1]); o.y = pk2(a[2], a[3]); o.z = pk2(b[0], b[1]); o.w = pk2(b[2], b[3]); return o; }

struct EpiZ {
    static constexpr bool PERM = true, HOOK = false;
    bf16_t* Z;
    __device__ __forceinline__ void operator()(const f32x4 (&acc)[2][2][4][2], const Unit& u, int wr, int wc, int fr_, int fq_) const {
        int fr = fr_, fq = fq_; asm volatile("" : "+v"(fr), "+v"(fq));
        const int mode = (u.pn >= 14 && u.pn < 26) ? 2 : ((u.pn >= 10 && u.pn < 14) ? 1 : 0);
        const int row0 = u.pm * 256 + wr * 64 + fr, col0 = u.pn * 256 + wc * 32 + 8 * fq;
        EPI_LOOP_ROWS { bf16_t* rp = Z + (size_t)(row0 + ai * 128 + m * 16) * NZ + col0;
#pragma unroll
            for (int bj = 0; bj < 2; ++bj) { f32x4 v0 = acc[ai][bj][m][0], v1 = acc[ai][bj][m][1];
                if (mode == 1) { _Pragma("unroll") for (int j = 0; j < 4; ++j) { v0[j] = gelu_exact(v0[j]); v1[j] = gelu_exact(v1[j]); } }
                else if (mode == 2) { _Pragma("unroll") for (int j = 0; j < 4; ++j) { v0[j] = sigmoidf_(v0[j]); v1[j] = sigmoidf_(v1[j]); } }
                if (mode == 2) stnt4(rp + bj * 128, pack8(v0, v1)); else *(uint4*)(rp + bj * 128) = pack8(v0, v1); } }
    }
};
struct EpiQ {
    static constexpr bool PERM = false, HOOK = false;
    bf16_t* Q; const float* rope;
    __device__ __forceinline__ void operator()(const f32x4 (&acc)[2][2][4][2], const Unit& u, int wr, int wc, int fr_, int fq_) const {
        int fr = fr_, fq = fq_; asm volatile("" : "+v"(fr), "+v"(fq));
        const int row0 = u.pm * 256 + wr * 64 + fr;
        const bool rp0 = (((u.pn * 256 + wc * 32) >> 5) % 3) == 2, rp1 = (((u.pn * 256 + 128 + wc * 32) >> 5) % 3) == 2, anyr = rp0 || rp1;
        f32x4 c0n = {1.f, 0.f, 1.f, 0.f}, c1n = c0n;
#define EQ_PIDX(row_) ((row_) < TP ? ((row_) & (SEQ - 1)) : (SEQ + (((row_) - TP) & (DSEQ - 1))))
        if (anyr) { const float* rp = rope + ((size_t)EQ_PIDX(row0) * 16 + 4 * fq) * 2; c0n = *(const f32x4*)rp; c1n = *(const f32x4*)(rp + 4); }
#pragma unroll
        for (int s8 = 0; s8 < 8; ++s8) { const int ai = s8 >> 2, m = s8 & 3; const int row = row0 + ai * 128 + m * 16; const f32x4 c0 = c0n, c1 = c1n;
            if (anyr && s8 + 1 < 8) { const int rown = row0 + ((s8 + 1) >> 2) * 128 + ((s8 + 1) & 3) * 16; const float* rp = rope + ((size_t)EQ_PIDX(rown) * 16 + 4 * fq) * 2; c0n = *(const f32x4*)rp; c1n = *(const f32x4*)(rp + 4); }
            const float cs[4] = {c0[0], c0[2], c1[0], c1[2]}, sn[4] = {c0[1], c0[3], c1[1], c1[3]};
#pragma unroll
            for (int bj = 0; bj < 2; ++bj) { const int cb = u.pn * 256 + bj * 128 + wc * 32; f32x4 v0 = acc[ai][bj][m][0] * QSCALE, v1 = acc[ai][bj][m][1] * QSCALE;
                if (bj ? rp1 : rp0) { _Pragma("unroll") for (int j = 0; j < 4; ++j) { const float a = v0[j], b = v1[j]; v0[j] = a * cs[j] - b * sn[j]; v1[j] = b * cs[j] + a * sn[j]; } }
                bf16_t* dp = Q + (size_t)row * 768 + cb + 4 * fq;
                *(uint2*)dp = make_uint2(pk2(v0[0], v0[1]), pk2(v0[2], v0[3])); *(uint2*)(dp + 16) = make_uint2(pk2(v1[0], v1[1]), pk2(v1[2], v1[3])); }
            __builtin_amdgcn_sched_barrier(0); }
#undef EQ_PIDX
    }
};
struct EpiKN {
    static constexpr bool PERM = true, HOOK = false;
    bf16_t* KN; bf16_t* KNS; int mode;
    __device__ __forceinline__ void operator()(const f32x4 (&acc)[2][2][4][2], const Unit& u, int wr, int wc, int fr_, int fq_) const {
        int fr = fr_, fq = fq_; asm volatile("" : "+v"(fr), "+v"(fq));
        const int row0 = u.pm * 256 + wr * 64 + fr, col0 = u.pn * 256 + wc * 32 + 8 * fq;
        EPI_LOOP_ROWS { const int row = row0 + ai * 128 + m * 16; bf16_t* rp;
            if (mode == 1) rp = KNS + ((size_t)(row >> 12) * KSS + (row & 4095)) * 512;
            else if (row < TP) rp = KN + (size_t)row * 512;
            else { const int s = row - TP; rp = KNS + ((size_t)(s >> 5) * KSS + PAST + (s & 31)) * 512; }
#pragma unroll
            for (int bj = 0; bj < 2; ++bj) *(uint4*)(rp + col0 + bj * 128) = pack8(acc[ai][bj][m][0], acc[ai][bj][m][1]); }
    }
};
struct EpiVT {
    static constexpr bool PERM = true, HOOK = false;
    bf16_t* VT; bf16_t* VTS; int mode;
    __device__ __forceinline__ void operator()(const f32x4 (&acc)[2][2][4][2], const Unit& u, int wr, int wc, int fr_, int fq_) const {
        int fr = fr_, fq = fq_; asm volatile("" : "+v"(fr), "+v"(fq));
        const int row0 = u.pm * 256 + wr * 64 + fr, col0 = u.pn * 256 + wc * 32 + 8 * fq;
        EPI_LOOP_ROWS { const int row = row0 + ai * 128 + m * 16;
#pragma unroll
            for (int bj = 0; bj < 2; ++bj) { const int col = col0 + bj * 128; bf16_t* dp;
                if (mode == 1) dp = VTS + ((size_t)(col >> 12) * 512 + row) * KSS + (col & 4095);
                else if (col < TP) dp = VT + ((size_t)(col >> 11) * 512 + row) * SEQ + (col & (SEQ - 1));
                else { const int s = col - TP; dp = VTS + ((size_t)(s >> 5) * 512 + row) * KSS + PAST + (s & 31); }
                *(uint4*)dp = pack8(acc[ai][bj][m][0], acc[ai][bj][m][1]); } }
    }
};
struct EpiMerge {
    static constexpr bool PERM = true, HOOK = true;
    bf16_t* Mo; const bf16_t* Z;
    __device__ __forceinline__ void mid(f32x4 (&acc)[2][2][4][2], const Unit& u, int t, int wr, int wc, int fr_, int fq_) const {
        int fr = fr_, fq = fq_; asm volatile("" : "+v"(fr), "+v"(fq));
        const int row0 = u.pm * 256 + wr * 64 + fr, col0 = u.pn * 256 + wc * 32 + 8 * fq; const int gp = (t == 8) ? ZGA : ZGB;
        const bf16_t* base = Z + (size_t)row0 * NZ + col0 + gp;
#define MG_OFF(s_) ((size_t)((((s_) >> 3) & 1) * 128 + (((s_) >> 1) & 3) * 16) * NZ + ((s_) & 1) * 128)
        uint4 pn = *(const uint4*)(base + MG_OFF(0)), qn = *(const uint4*)(base + MG_OFF(0) + 1024);
#pragma unroll
        for (int st = 0; st < 16; ++st) { const int ai = st >> 3, m = (st >> 1) & 3, bj = st & 1; const uint4 p = pn, q = qn;
            if (st + 1 < 16) { pn = *(const uint4*)(base + MG_OFF(st + 1)); qn = *(const uint4*)(base + MG_OFF(st + 1) + 1024); }
            const unsigned pu[4] = {p.x, p.y, p.z, p.w}, qu[4] = {q.x, q.y, q.z, q.w};
#pragma unroll
            for (int n = 0; n < 2; ++n)
#pragma unroll
                for (int j = 0; j < 4; ++j) { const unsigned a_ = pu[n * 2 + (j >> 1)], b_ = qu[n * 2 + (j >> 1)];
                    const float sp = (j & 1) ? hi16(a_) : lo16(a_), sq = (j & 1) ? hi16(b_) : lo16(b_);
                    acc[ai][bj][m][n][j] *= sp * __builtin_amdgcn_rcpf(fmaxf(sq, 1e-30f)); }
            __builtin_amdgcn_sched_barrier(0); }
#undef MG_OFF
    }
    __device__ __forceinline__ void operator()(const f32x4 (&acc)[2][2][4][2], const Unit& u, int wr, int wc, int fr_, int fq_) const {
        int fr = fr_, fq = fq_; asm volatile("" : "+v"(fr), "+v"(fq));
        const int row0 = u.pm * 256 + wr * 64 + fr, col0 = u.pn * 256 + wc * 32 + 8 * fq;
        const bf16_t* base = Z + (size_t)row0 * NZ + ZGC + col0;
#define MG_OFF(s_) ((size_t)((((s_) >> 3) & 1) * 128 + (((s_) >> 1) & 3) * 16) * NZ + ((s_) & 1) * 128)
        uint4 pn = *(const uint4*)(base + MG_OFF(0));
#pragma unroll
        for (int st = 0; st < 16; ++st) { const int ai = st >> 3, m = (st >> 1) & 3, bj = st & 1; const uint4 p = pn; const int row = row0 + ai * 128 + m * 16;
            if (st + 1 < 16) pn = *(const uint4*)(base + MG_OFF(st + 1));
            const unsigned pu[4] = {p.x, p.y, p.z, p.w};
            f32x4 v0 = acc[ai][bj][m][0], v1 = acc[ai][bj][m][1];
            v0[0] *= lo16(pu[0]); v0[1] *= hi16(pu[0]); v0[2] *= lo16(pu[1]); v0[3] *= hi16(pu[1]);
            v1[0] *= lo16(pu[2]); v1[1] *= hi16(pu[2]); v1[2] *= lo16(pu[3]); v1[3] *= hi16(pu[3]);
            *(uint4*)(Mo + (size_t)row * 1024 + col0 + bj * 128) = pack8(v0, v1); }
#undef MG_OFF
    }
};
struct EpiRes {
    static constexpr bool PERM = false, HOOK = false;
    float* X; const float* ST; const float* G; const float* B;
    __device__ __forceinline__ void operator()(const f32x4 (&acc)[2][2][4][2], const Unit& u, int wr, int wc, int fr_, int fq_) const {
        int fr = fr_, fq = fq_; asm volatile("" : "+v"(fr), "+v"(fq));
        const int row0 = u.pm * 256 + wr * 64 + fr, col0 = u.pn * 256 + wc * 32 + 4 * fq;
        f32x4 gv[2][2], bv[2][2];
        if (ST) {
#pragma unroll
            for (int bj = 0; bj < 2; ++bj)
#pragma unroll
                for (int n = 0; n < 2; ++n) { gv[bj][n] = *(const f32x4*)(G + col0 + bj * 128 + n * 16); bv[bj][n] = *(const f32x4*)(B + col0 + bj * 128 + n * 16); } }
        f32x4 xn[2][2]; f32x2 stn = {0.f, 1.f};
        {   const float* rp0 = X + (size_t)row0 * 1024 + col0;
#pragma unroll
            for (int bj = 0; bj < 2; ++bj)
#pragma unroll
                for (int n = 0; n < 2; ++n) xn[bj][n] = *(const f32x4*)(rp0 + bj * 128 + n * 16);
            if (ST) stn = *(const f32x2*)(ST + (size_t)row0 * 2); }
#pragma unroll
        for (int s = 0; s < 8; ++s) { const int ai = s >> 2, m = s & 3; const int row = row0 + ai * 128 + m * 16; float* rp = X + (size_t)row * 1024 + col0;
            f32x4 xc[2][2]; const f32x2 st = stn;
#pragma unroll
            for (int bj = 0; bj < 2; ++bj)
#pragma unroll
                for (int n = 0; n < 2; ++n) xc[bj][n] = xn[bj][n];
            if (s + 1 < 8) { const int rown = row0 + ((s + 1) >> 2) * 128 + ((s + 1) & 3) * 16; const float* rpn = X + (size_t)rown * 1024 + col0;
#pragma unroll
                for (int bj = 0; bj < 2; ++bj)
#pragma unroll
                    for (int n = 0; n < 2; ++n) xn[bj][n] = *(const f32x4*)(rpn + bj * 128 + n * 16);
                if (ST) stn = *(const f32x2*)(ST + (size_t)rown * 2); }
#pragma unroll
            for (int bj = 0; bj < 2; ++bj)
#pragma unroll
                for (int n = 0; n < 2; ++n) { f32x4 x = xc[bj][n]; if (ST) x = (x - st[0]) * st[1] * gv[bj][n] + bv[bj][n]; *(f32x4*)(rp + bj * 128 + n * 16) = x * ALPHA + acc[ai][bj][m][n]; }
            __builtin_amdgcn_sched_barrier(0); }
    }
};
struct EpiUp {
    static constexpr bool PERM = true, HOOK = false;
    bf16_t* H;
    __device__ __forceinline__ void operator()(const f32x4 (&acc)[2][2][4][2], const Unit& u, int wr, int wc, int fr_, int fq_) const {
        int fr = fr_, fq = fq_; asm volatile("" : "+v"(fr), "+v"(fq));
        const int row0 = u.pm * 256 + wr * 64 + fr, col0 = u.pn * 128 + wc * 32 + 8 * fq;
        EPI_LOOP_ROWS { f32x4 v0, v1;
#pragma unroll
            for (int j = 0; j < 4; ++j) { const float g0 = acc[ai][0][m][0][j], g1 = acc[ai][0][m][1][j];
                v0[j] = g0 * sigmoidf_(g0) * acc[ai][1][m][0][j]; v1[j] = g1 * sigmoidf_(g1) * acc[ai][1][m][1][j]; }
            *(uint4*)(H + (size_t)(row0 + ai * 128 + m * 16) * DFF + col0) = pack8(v0, v1); }
    }
};


struct EpiKV4 {
    static constexpr bool PERM = true, HOOK = false;
    EpiKN kn0, kn1; EpiVT vt0, vt1;
    __device__ __forceinline__ void operator()(const f32x4 (&acc)[2][2][4][2], const Unit& u, int wr, int wc, int fr, int fq) const {
        if (u.g == 0) kn0(acc, u, wr, wc, fr, fq); else if (u.g == 1) vt0(acc, u, wr, wc, fr, fq); else if (u.g == 2) kn1(acc, u, wr, wc, fr, fq); else vt1(acc, u, wr, wc, fr, fq);
    }
};
struct KV4Order {
    int G, c; long oW, oWv, oC, oX;
    __device__ bool next(int i, Unit& u) const {
        int L;
        if (G != 256) { L = i * G + c; if (L >= 772) return false; }
        else if (i < 3) L = i * 256 + c;
        else { const int e = c - 195; if (i > 3 || e < 0 || e >= 4) return false; L = 768 + e; }
        int g, idx;
        if (L < 130) { g = 0; idx = L; } else if (L < 260) { g = 1; idx = L - 130; } else if (L < 516) { g = 2; idx = L - 260; } else { g = 3; idx = L - 516; }
        u.g = g;
        if (g == 0 || g == 2) { u.pm = idx >> 1; u.pn = idx & 1; } else { const int nn = (g == 1) ? 65 : 128; u.pm = idx / nn; u.pn = idx - u.pm * nn; }
        u.ao = oC + (long)(g & 1) * (oWv - oC) + (long)(g == 2) * (oX - oC); u.bo = oW + (long)(g == 1) * (oC - oW) + (long)(g == 3) * (oX - oW); return true;
    }
};

template <class Epi>
__device__ __forceinline__ void run_gemm(unsigned char* smem, const bf16_t* A, int lda, const bf16_t* Bt, int ldb, int M, int N, int K, int rot, const Epi& E) {
    int Kop = K; asm volatile("" : "+s"(Kop));
    pg8::Gemm g; g.A = A; g.Bt = Bt; g.M = M; g.N = N; g.K = Kop; g.lda = lda; g.ldb = ldb;
    pg8::StaticOrder S; S.init(M, N, (int)gridDim.x, (int)((blockIdx.x + gridDim.x - (rot % gridDim.x)) % gridDim.x));
    pg8::gemm_phase<Epi, pg8::StaticOrder>((LAS unsigned char*)smem, g, S, E);
    __syncthreads();
}


template <int NSEG, int MODE>
__device__ __forceinline__ void skinny_gemm(unsigned char* smem, const Params& p, const bf16_t* A, int lda, const bf16_t* Bt, int ldb, int Kseg, const float* ST = nullptr, const float* Gp = nullptr, const float* Bp = nullptr) {
    const int tid = opaque_tid(), lane = tid & 63, w = tid >> 6, fr = lane & 15, fq = lane >> 4;
    float* part = (float*)smem;
    for (int tile = blockIdx.x; tile < 256; tile += gridDim.x) {
        const int rt = tile >> 5, ct = tile & 31;
        const bf16_t* ap = A + (size_t)(TP + 32 * rt + fr) * lda + fq * 8;
        const bf16_t* bp = Bt + (size_t)(32 * ct + fr) * ldb + fq * 8;
#pragma unroll
        for (int seg = 0; seg < NSEG; ++seg) {
            f32x4 acc[2][2];
#pragma unroll
            for (int i = 0; i < 2; ++i) { acc[i][0] = (f32x4){0.f, 0.f, 0.f, 0.f}; acc[i][1] = (f32x4){0.f, 0.f, 0.f, 0.f}; }
#pragma unroll 4
            for (int st = w; st < (Kseg >> 5); st += 8) { const int k0 = seg * Kseg + st * 32;
                const bf16x8 a0 = *(const bf16x8*)(ap + k0), a1 = *(const bf16x8*)(ap + (size_t)16 * lda + k0);
                const bf16x8 b0 = *(const bf16x8*)(bp + k0), b1 = *(const bf16x8*)(bp + (size_t)16 * ldb + k0);
                acc[0][0] = mfma16(b0, a0, acc[0][0]); acc[0][1] = mfma16(b1, a0, acc[0][1]); acc[1][0] = mfma16(b0, a1, acc[1][0]); acc[1][1] = mfma16(b1, a1, acc[1][1]); }
#pragma unroll
            for (int mt = 0; mt < 2; ++mt)
#pragma unroll
                for (int nt = 0; nt < 2; ++nt) *(f32x4*)(part + ((size_t)((seg * 8 + w) * 32 + mt * 16 + fr)) * 32 + nt * 16 + 4 * fq) = acc[mt][nt];
        }
        __syncthreads();
        {   const int row = tid >> 4, c0 = (tid & 15) * 2; const int rg = TP + 32 * rt + row, cg_ = 32 * ct + c0;
            float v[NSEG][2];
#pragma unroll
            for (int seg = 0; seg < NSEG; ++seg) { v[seg][0] = 0.f; v[seg][1] = 0.f;
#pragma unroll
                for (int ww = 0; ww < 8; ++ww) { const f32x2 t = *(const f32x2*)(part + ((size_t)((seg * 8 + ww) * 32 + row)) * 32 + c0); v[seg][0] += t[0]; v[seg][1] += t[1]; } }
            if (MODE == 0) { f32x2* xp = (f32x2*)(p.out + O_YP + (size_t)rg * 1024 + cg_); f32x2 x = *xp;
                if (ST) { const f32x2 st = *(const f32x2*)(ST + (size_t)rg * 2); const f32x2 g2 = *(const f32x2*)(Gp + cg_), b2 = *(const f32x2*)(Bp + cg_); x = (x - st[0]) * st[1] * g2 + b2; }
                x[0] = x[0] * ALPHA + v[0][0]; x[1] = x[1] * ALPHA + v[0][1]; *xp = x; }
            else { const bf16_t* Z = (const bf16_t*)(p.ws + WS_Z); float o0 = 0.f, o1 = 0.f;
#pragma unroll
                for (int seg = 0; seg < NSEG; ++seg) { const unsigned gte = *(const unsigned*)(Z + (size_t)rg * NZ + ZGA + 1024 * seg + cg_); o0 += lo16(gte) * v[seg][0]; o1 += hi16(gte) * v[seg][1]; }
                *(unsigned*)((bf16_t*)(p.ws + WS_XB) + (size_t)rg * 1024 + cg_) = pk2(o0, o1); }
        }
        __syncthreads();
    }
}

__device__ __forceinline__ int srccol(int map, int n) {
    if (map == 0) return n;
    if (map == 1) { if (n < 512) return n; if (n < ZKR) return n + 32; if (n < ZKR + 32) return n - ZKR + 512; return -1; }
    const int u = n >> 8, bj = (n >> 7) & 1, j = n & 127; return bj * DFF + u * 128 + j;
}
__device__ __forceinline__ void conv_w(unsigned char* smem, const float* src, int ldsrc, int K, bf16_t* dst, int ldd, int koff, int Ndst, int map, int& base) {
    const int tid = opaque_tid(), G = gridDim.x, nk = K >> 6, ntl = (Ndst >> 6) * nk;
    bf16_t* T = (bf16_t*)smem;
    const int first = ((int)blockIdx.x - (base % G) + G) % G;
    const int c4 = (tid & 15) * 4, r = tid >> 4;
    f32x4 v0 = {0.f, 0.f, 0.f, 0.f}, v1 = {0.f, 0.f, 0.f, 0.f};
#define CONV_LOAD(tile_) do { const int tn_ = (tile_) / nk, tk_ = (tile_) - tn_ * nk; const int sc_ = srccol(map, tn_ * 64 + c4); v0 = (f32x4){0.f, 0.f, 0.f, 0.f}; v1 = v0; \
        if (sc_ >= 0) { v0 = __builtin_nontemporal_load((const f32x4*)(src + (size_t)(tk_ * 64 + r) * ldsrc + sc_)); v1 = __builtin_nontemporal_load((const f32x4*)(src + (size_t)(tk_ * 64 + r + 32) * ldsrc + sc_)); } } while (0)
    if (first < ntl) CONV_LOAD(first);
    for (int tile = first; tile < ntl; tile += G) {
        const int tn = tile / nk, tk = tile - tn * nk, n0 = tn * 64, k0 = tk * 64;
        const f32x4 a0 = v0, a1 = v1;
        if (tile + G < ntl) CONV_LOAD(tile + G);
        T[(c4 + 0) * 72 + r] = f2bf(a0[0]); T[(c4 + 1) * 72 + r] = f2bf(a0[1]); T[(c4 + 2) * 72 + r] = f2bf(a0[2]); T[(c4 + 3) * 72 + r] = f2bf(a0[3]);
        T[(c4 + 0) * 72 + r + 32] = f2bf(a1[0]); T[(c4 + 1) * 72 + r + 32] = f2bf(a1[1]); T[(c4 + 2) * 72 + r + 32] = f2bf(a1[2]); T[(c4 + 3) * 72 + r + 32] = f2bf(a1[3]);
        __syncthreads();
        const int row = tid >> 3, seg = tid & 7;
        *(uint4*)(dst + (size_t)(n0 + row) * ldd + koff + k0 + seg * 8) = *(const uint4*)(T + row * 72 + seg * 8);
        __syncthreads();
    }
#undef CONV_LOAD
    base += ntl;
}
__device__ __forceinline__ void conv_layer(unsigned char* smem, const Params& p, int l) {
    bf16_t* W = (bf16_t*)(p.ws + WS_WT); int base = 0;
    conv_w(smem, p.in[7] + (size_t)l * 1024 * 6688, 6688, 1024, W + W_IN, 1024, 0, NZ, 1, base);
    conv_w(smem, p.in[9] + (size_t)l * 256 * 768, 768, 256, W + W_UQ, 256, 0, 768, 0, base);
    conv_w(smem, p.in[10] + (size_t)l * 256 * 512, 512, 256, W + W_UKV, 256, 0, 512, 0, base);
    conv_w(smem, p.in[12] + (size_t)l * 256 * 512, 512, 256, W + W_UKV + 512 * 256, 256, 0, 512, 0, base);
    conv_w(smem, p.in[19] + (size_t)l * 512 * 1024, 1024, 512, W + W_CAT, 1536, 0, 1024, 0, base);
    conv_w(smem, p.in[20] + (size_t)l * 512 * 1024, 1024, 512, W + W_CAT, 1536, 512, 1024, 0, base);
    conv_w(smem, p.in[21] + (size_t)l * 512 * 1024, 1024, 512, W + W_CAT, 1536, 1024, 1024, 0, base);
    conv_w(smem, p.in[22] + (size_t)l * 1024 * 1024, 1024, 1024, W + W_O, 1024, 0, 1024, 0, base);
    conv_w(smem, p.in[25] + (size_t)l * 1024 * 5632, 5632, 1024, W + W_UP, 1024, 0, 5632, 2, base);
    conv_w(smem, p.in[26] + (size_t)l * DFF * 1024, 1024, DFF, W + W_DN, DFF, 0, 1024, 0, base);
}

__device__ __forceinline__ void ln_rows(const float* srcP, const float* srcS, float* X, bf16_t* XB, const float* g, const float* b, float* ST, bool writeX) {
    const int tid_ = opaque_tid(); const int lane = tid_ & 63, gw = blockIdx.x * 8 + (tid_ >> 6), nw = gridDim.x * 8;
    f32x4 gv[4], bv[4];
#pragma unroll
    for (int i = 0; i < 4; ++i) { gv[i] = *(const f32x4*)(g + i * 256 + lane * 4); bv[i] = *(const f32x4*)(b + i * 256 + lane * 4); }
    f32x4 vn[2][4];
#define LN_LOAD(r0_) do { const int ra_ = (r0_), rb_ = ((r0_) + nw < TT) ? (r0_) + nw : (r0_); \
        const float* pa_ = (ra_ < TP) ? srcP + (size_t)ra_ * 1024 : srcS + (size_t)(ra_ - TP) * 1024; const float* pb_ = (rb_ < TP) ? srcP + (size_t)rb_ * 1024 : srcS + (size_t)(rb_ - TP) * 1024; \
        _Pragma("unroll") for (int i = 0; i < 4; ++i) { vn[0][i] = *(const f32x4*)(pa_ + i * 256 + lane * 4); vn[1][i] = *(const f32x4*)(pb_ + i * 256 + lane * 4); } } while (0)
    if (gw < TT) LN_LOAD(gw);
    for (int row0 = gw; row0 < TT; row0 += 2 * nw) {
        const int row1 = row0 + nw; const bool has1 = row1 < TT;
        f32x4 v[2][4]; float s0 = 0.f, s1 = 0.f;
#pragma unroll
        for (int i = 0; i < 4; ++i) { v[0][i] = vn[0][i]; v[1][i] = vn[1][i]; }
        if (row0 + 2 * nw < TT) LN_LOAD(row0 + 2 * nw);
#pragma unroll
        for (int i = 0; i < 4; ++i) { s0 += v[0][i][0] + v[0][i][1] + v[0][i][2] + v[0][i][3]; s1 += v[1][i][0] + v[1][i][1] + v[1][i][2] + v[1][i][3]; }
        s0 = wave_sum(s0); s1 = wave_sum(s1);
        const float mu0 = s0 * (1.0f / 1024.0f), mu1 = s1 * (1.0f / 1024.0f); float q0 = 0.f, q1 = 0.f;
#pragma unroll
        for (int i = 0; i < 4; ++i) { v[0][i] = v[0][i] - mu0; v[1][i] = v[1][i] - mu1;
            q0 += v[0][i][0] * v[0][i][0] + v[0][i][1] * v[0][i][1] + v[0][i][2] * v[0][i][2] + v[0][i][3] * v[0][i][3];
            q1 += v[1][i][0] * v[1][i][0] + v[1][i][1] * v[1][i][1] + v[1][i][2] * v[1][i][2] + v[1][i][3] * v[1][i][3]; }
        q0 = wave_sum(q0); q1 = wave_sum(q1);
        const float rs0 = rsqrtf(q0 * (1.0f / 1024.0f) + EPS), rs1 = rsqrtf(q1 * (1.0f / 1024.0f) + EPS);
        if (ST && lane == 0) { *(f32x2*)(ST + (size_t)row0 * 2) = (f32x2){mu0, rs0}; if (has1) *(f32x2*)(ST + (size_t)row1 * 2) = (f32x2){mu1, rs1}; }
#pragma unroll
        for (int i = 0; i < 4; ++i) { const f32x4 o = v[0][i] * rs0 * gv[i] + bv[i];
            if (writeX) *(f32x4*)(X + (size_t)row0 * 1024 + i * 256 + lane * 4) = o;
            *(uint2*)(XB + (size_t)row0 * 1024 + i * 256 + lane * 4) = make_uint2(pk2(o[0], o[1]), pk2(o[2], o[3])); }
        if (has1) {
#pragma unroll
            for (int i = 0; i < 4; ++i) { const f32x4 o = v[1][i] * rs1 * gv[i] + bv[i];
                if (writeX) *(f32x4*)(X + (size_t)row1 * 1024 + i * 256 + lane * 4) = o;
                *(uint2*)(XB + (size_t)row1 * 1024 + i * 256 + lane * 4) = make_uint2(pk2(o[0], o[1]), pk2(o[2], o[3])); } }
    }
}

__device__ __forceinline__ void rowops(const Params& p, int l) {
    const int tid_ = opaque_tid(); const int lane = tid_ & 63, gw = blockIdx.x * 8 + (tid_ >> 6), nw = gridDim.x * 8;
    bf16_t* Z = (bf16_t*)(p.ws + WS_Z); const float* rope = (const float*)(p.ws + WS_ROPE);
    bf16_t* KRB = (bf16_t*)(p.ws + WS_KRB); bf16_t* KRS = (bf16_t*)(p.ws + WS_KRS);
    const f32x4 gq = *(const f32x4*)(p.in[8] + l * 256 + lane * 4), gk = *(const f32x4*)(p.in[11] + l * 256 + lane * 4);
    const f32x4 lg0 = *(const f32x4*)(p.in[15] + l * 512 + lane * 8), lg1 = *(const f32x4*)(p.in[15] + l * 512 + lane * 8 + 4);
    const f32x4 lb0 = *(const f32x4*)(p.in[16] + l * 512 + lane * 8), lb1 = *(const f32x4*)(p.in[16] + l * 512 + lane * 8 + 4);
    uint2 uqn[2], ukn[2]; uint4 uvn[2]; bf16_t x1n[2], x2n[2];
#define RO_LOAD(t0_) do { const int ta_[2] = {(t0_), ((t0_) + nw < TT) ? (t0_) + nw : (t0_)}; \
        _Pragma("unroll") for (int e = 0; e < 2; ++e) { const bf16_t* zr = Z + (size_t)ta_[e] * NZ; \
            uqn[e] = *(const uint2*)(zr + ZCQ + lane * 4); ukn[e] = *(const uint2*)(zr + ZCKV + lane * 4); uvn[e] = *(const uint4*)(zr + ZCV + lane * 8); \
            x1n[e] = zr[ZKR + (lane & 15)]; x2n[e] = zr[ZKR + 16 + (lane & 15)]; } } while (0)
    if (gw < TT) RO_LOAD(gw);
    for (int tok0 = gw; tok0 < TT; tok0 += 2 * nw) {
        const bool has1 = tok0 + nw < TT; const int toks[2] = {tok0, has1 ? tok0 + nw : tok0};
        uint2 uq[2], uk[2]; uint4 uv[2]; float x1[2], x2[2];
#pragma unroll
        for (int e = 0; e < 2; ++e) { uq[e] = uqn[e]; uk[e] = ukn[e]; uv[e] = uvn[e]; x1[e] = bf2f(x1n[e]); x2[e] = bf2f(x2n[e]); }
        if (tok0 + 2 * nw < TT) RO_LOAD(tok0 + 2 * nw);
        f32x4 vq[2], vk[2], va[2], vc[2]; float sq[2], sk[2], sv[2];
#pragma unroll
        for (int e = 0; e < 2; ++e) { vq[e] = (f32x4){lo16(uq[e].x), hi16(uq[e].x), lo16(uq[e].y), hi16(uq[e].y)}; vk[e] = (f32x4){lo16(uk[e].x), hi16(uk[e].x), lo16(uk[e].y), hi16(uk[e].y)};
            va[e] = (f32x4){lo16(uv[e].x), hi16(uv[e].x), lo16(uv[e].y), hi16(uv[e].y)}; vc[e] = (f32x4){lo16(uv[e].z), hi16(uv[e].z), lo16(uv[e].w), hi16(uv[e].w)};
            sq[e] = vq[e][0] * vq[e][0] + vq[e][1] * vq[e][1] + vq[e][2] * vq[e][2] + vq[e][3] * vq[e][3];
            sk[e] = vk[e][0] * vk[e][0] + vk[e][1] * vk[e][1] + vk[e][2] * vk[e][2] + vk[e][3] * vk[e][3];
            sv[e] = va[e][0] + va[e][1] + va[e][2] + va[e][3] + vc[e][0] + vc[e][1] + vc[e][2] + vc[e][3]; }
#pragma unroll
        for (int e = 0; e < 2; ++e) { sq[e] = wave_sum(sq[e]); sk[e] = wave_sum(sk[e]); sv[e] = wave_sum(sv[e]); }
        float s2[2];
#pragma unroll
        for (int e = 0; e < 2; ++e) { const float mu = sv[e] * (1.0f / 512.0f); va[e] = va[e] - mu; vc[e] = vc[e] - mu;
            s2[e] = va[e][0] * va[e][0] + va[e][1] * va[e][1] + va[e][2] * va[e][2] + va[e][3] * va[e][3] + vc[e][0] * vc[e][0] + vc[e][1] * vc[e][1] + vc[e][2] * vc[e][2] + vc[e][3] * vc[e][3]; }
#pragma unroll
        for (int e = 0; e < 2; ++e) s2[e] = wave_sum(s2[e]);
#pragma unroll
        for (int e = 0; e < 2; ++e) {
            if (e == 1 && !has1) break;
            const int tok = toks[e]; bf16_t* zr = Z + (size_t)tok * NZ; const bool smp = tok >= TP; const int s = tok - TP;
            {   const f32x4 v = vq[e] * rsqrtf(sq[e] * (1.0f / 256.0f) + EPS) * gq; *(uint2*)(zr + ZCQ + lane * 4) = make_uint2(pk2(v[0], v[1]), pk2(v[2], v[3])); }
            {   const f32x4 v = vk[e] * rsqrtf(sk[e] * (1.0f / 256.0f) + EPS) * gk; *(uint2*)((bf16_t*)(p.ws + WS_CKVN) + (size_t)tok * 256 + lane * 4) = make_uint2(pk2(v[0], v[1]), pk2(v[2], v[3]));
                float* op = smp ? p.out + O_CKVS + ((size_t)l * TS + s) * 256 : p.out + O_CKVP + ((size_t)l * TP + tok) * 256;
                __builtin_nontemporal_store(v, (f32x4*)(op + lane * 4)); }
            if (lane < 16) {
                const int pidx = smp ? SEQ + (s & 31) : (tok & (SEQ - 1));
                const f32x2 cs = *(const f32x2*)(rope + ((size_t)pidx * 16 + lane) * 2);
                const float o1 = x1[e] * cs[0] - x2[e] * cs[1], o2 = x2[e] * cs[0] + x1[e] * cs[1];
                float* op = smp ? p.out + O_KRS + ((size_t)l * TS + s) * 32 : p.out + O_KRP + ((size_t)l * TP + tok) * 32;
                op[lane] = o1; op[16 + lane] = o2;
                bf16_t* kb = smp ? KRS + ((size_t)(s >> 5) * KSS + PAST + (s & 31)) * 32 : KRB + (size_t)tok * 32;
                kb[lane] = f2bf(o1); kb[16 + lane] = f2bf(o2); }
            {   const float rs = rsqrtf(s2[e] * (1.0f / 512.0f) + EPS); const f32x4 a = va[e] * rs * lg0 + lb0, c = vc[e] * rs * lg1 + lb1;
                *(uint4*)(zr + ZCV + lane * 8) = pack8(a, c);
                if (smp) { float* op = p.out + O_VS + ((size_t)l * TS + s) * 512 + lane * 8; *(f32x4*)op = a; *(f32x4*)(op + 4) = c; } }
        }
    }
}
__device__ __forceinline__ void cache_conv(const Params& p, int l) {
    const size_t gt = (size_t)blockIdx.x * 512 + opaque_tid(), nth = (size_t)gridDim.x * 512;
    const float* src = p.in[2] + (size_t)l * 8 * PAST * 256; bf16_t* dst = (bf16_t*)(p.ws + WS_XB);
    constexpr size_t NC = (size_t)8 * PAST * 256 / 8;
    for (size_t i = gt; i < NC; i += 4 * nth) { f32x4 a[4], b[4];
#pragma unroll
        for (int e = 0; e < 4; ++e) { const size_t j = i + e * nth; if (j < NC) { a[e] = __builtin_nontemporal_load((const f32x4*)(src + j * 8)); b[e] = __builtin_nontemporal_load((const f32x4*)(src + j * 8 + 4)); } }
#pragma unroll
        for (int e = 0; e < 4; ++e) { const size_t j = i + e * nth; if (j < NC) *(uint4*)(dst + j * 8) = pack8(a[e], b[e]); } }
    const float* ks = p.in[3] + (size_t)l * 8 * PAST * 32; bf16_t* KRS = (bf16_t*)(p.ws + WS_KRS);
    for (size_t i = gt; i < (size_t)8 * PAST * 32 / 8; i += nth) { const f32x4 a = *(const f32x4*)(ks + i * 8), b = *(const f32x4*)(ks + i * 8 + 4);
        const size_t row = i >> 2, bb = row >> 12, key = row & 4095; *(uint4*)(KRS + (bb * KSS + key) * 32 + (i & 3) * 8) = pack8(a, b); }
}

__device__ __forceinline__ void hg_item(int it, int& tok0, int& nrows, int& b, int& h) {
    if (it < 1024) { const int sq = it >> 5, c = it & 31; b = sq >> 2; h = sq & 3; tok0 = b * SEQ + c * 64; nrows = 64; }
    else { const int si = it - 1024; b = si >> 2; h = si & 3; tok0 = TP + b * DSEQ; nrows = 32; }
}
__device__ __forceinline__ void hg_stage(bf16_t* dst, const bf16_t* Z, int tok0, int nrows, int col, int tid) {
#pragma unroll
    for (int i = 0; i < 2; ++i) { const int c = tid + 512 * i, row = c >> 4, seg = c & 15; uint4 v = make_uint4(0, 0, 0, 0);
        if (row < nrows) v = *(const uint4*)(Z + (size_t)(tok0 + row) * NZ + col + seg * 8);
        *(uint4*)(dst + row * 136 + seg * 8) = v; }
}
__device__ __forceinline__ void hg_store16(bf16_t* dst, const float (&x)[16]) {
    uint4 a, b; a.x = pk2(x[0], x[1]); a.y = pk2(x[2], x[3]); a.z = pk2(x[4], x[5]); a.w = pk2(x[6], x[7]); b.x = pk2(x[8], x[9]); b.y = pk2(x[10], x[11]); b.z = pk2(x[12], x[13]); b.w = pk2(x[14], x[15]);
    *(uint4*)dst = a; *(uint4*)(dst + 8) = b;
}
__device__ __forceinline__ void hgrn_pass1(unsigned char* smem, const Params& p, int l, int it) {
    const int tid = opaque_tid(), lane = tid & 63, w = tid >> 6, fr = lane & 15, fq = lane >> 4;
    int tok0, nrows, b, h; hg_item(it, tok0, nrows, b, h);
    const bf16_t* Z = (const bf16_t*)(p.ws + WS_Z);
    bf16_t* Zf = (bf16_t*)smem;
    bf16_t* Zi = Zf + 64 * 136;
    bf16_t* KdT = Zi + 64 * 136;
    bf16_t* VT = KdT + 128 * 72;
    float* tot = (float*)(VT + 128 * 72);
    hg_stage(Zf, Z, tok0, nrows, ZHF + h * 128, tid); hg_stage(Zi, Z, tok0, nrows, ZHI + h * 128, tid);
    __syncthreads();
    const int k = tid & 127, part = tid >> 7; const float lb = ((const float*)(p.ws + WS_LB))[l * 512 + h * 128 + k];
    float cs[16], kk[16], vv[16]; float run = 0.f;
#pragma unroll
    for (int i = 0; i < 16; ++i) { const int t = part * 16 + i;
        if (t < nrows) { const float sg = sigmoidf_(bf2f(Zf[t * 136 + k])); run += __logf(lb + (1.0f - lb) * sg + 1e-30f); kk[i] = (1.0f - lb) * (1.0f - sg); }
        else kk[i] = 0.f;
        vv[i] = bf2f(Zi[t * 136 + k]); cs[i] = run; }
    tot[part * 128 + k] = run;
    hg_store16(VT + k * 72 + part * 16, vv);
    __syncthreads();
    float pre = 0.f, bL = 0.f;
#pragma unroll
    for (int q = 0; q < 4; ++q) { const float tv = tot[q * 128 + k]; bL += tv; if (q < part) pre += tv; }
#pragma unroll
    for (int i = 0; i < 16; ++i) kk[i] = kk[i] * __expf(bL - (pre + cs[i]));
    hg_store16(KdT + k * 72 + part * 16, kk);
    if (part == 0) ((float*)(p.ws + WS_HD))[(size_t)it * 128 + k] = __expf(bL);
    __syncthreads();
    bf16x8 vf[2];
#pragma unroll
    for (int ks = 0; ks < 2; ++ks) vf[ks] = *(const bf16x8*)(VT + (16 * w + fr) * 72 + ks * 32 + fq * 8);
    bf16_t* HS = (bf16_t*)(p.ws + WS_HS) + (size_t)it * 16384;
#pragma unroll
    for (int nt = 0; nt < 8; ++nt) { f32x4 acc = {0.f, 0.f, 0.f, 0.f};
#pragma unroll
        for (int ks = 0; ks < 2; ++ks) { const bf16x8 kf = *(const bf16x8*)(KdT + (16 * nt + fr) * 72 + ks * 32 + fq * 8); acc = mfma16(kf, vf[ks], acc); }
        *(uint2*)(HS + (size_t)(16 * w + fr) * 128 + 16 * nt + 4 * fq) = make_uint2(pk2(acc[0], acc[1]), pk2(acc[2], acc[3])); }
    __syncthreads();
}
__device__ __forceinline__ void hgrn_scan(const Params& p, int l, int item) {
    const int tid = opaque_tid(), sq = item >> 4, vb = item & 15, v = vb * 8 + (tid >> 6), k0 = (tid & 63) * 2;
    bf16_t* HS = (bf16_t*)(p.ws + WS_HS); const float* HD = (const float*)(p.ws + WS_HD);
    if (sq < 32) { const int b = sq >> 2, h = sq & 3, it0 = sq * 32; float* outp = p.out + O_HSP + (size_t)((l * 8 + b) * 4 + h) * 16384;
        unsigned u[32]; f32x2 d[32];
#pragma unroll
        for (int c = 0; c < 32; ++c) { u[c] = *(const unsigned*)(HS + (size_t)(it0 + c) * 16384 + v * 128 + k0); d[c] = *(const f32x2*)(HD + (size_t)(it0 + c) * 128 + k0); }
        float r0 = 0.f, r1 = 0.f;
#pragma unroll
        for (int c = 0; c < 32; ++c) { *(unsigned*)(HS + (size_t)(it0 + c) * 16384 + v * 128 + k0) = pk2(r0, r1); r0 = d[c][0] * r0 + lo16(u[c]); r1 = d[c][1] * r1 + hi16(u[c]); }
        outp[(size_t)k0 * 128 + v] = r0; outp[(size_t)(k0 + 1) * 128 + v] = r1;
    } else { const int si = sq - 32, b = si >> 2, h = si & 3, it0 = 1024 + si; float* outp = p.out + O_HSS + (size_t)((l * 8 + b) * 4 + h) * 16384;
        const float* st = p.in[4] + (size_t)((l * 8 + b) * 4 + h) * 16384;
        float r0 = st[(size_t)k0 * 128 + v], r1 = st[(size_t)(k0 + 1) * 128 + v];
        bf16_t* hp = HS + (size_t)it0 * 16384 + v * 128 + k0; const unsigned u = *(const unsigned*)hp; const f32x2 d = *(const f32x2*)(HD + (size_t)it0 * 128 + k0);
        *(unsigned*)hp = pk2(r0, r1); r0 = d[0] * r0 + lo16(u); r1 = d[1] * r1 + hi16(u);
        outp[(size_t)k0 * 128 + v] = r0; outp[(size_t)(k0 + 1) * 128 + v] = r1; }
}
__device__ __forceinline__ void hgrn_pass3(unsigned char* smem, const Params& p, int l, int it) {
    const int tid = opaque_tid(), lane = tid & 63, w = tid >> 6, fr = lane & 15, fq = lane >> 4;
    int tok0, nrows, b, h; hg_item(it, tok0, nrows, b, h);
    const bf16_t* Z = (const bf16_t*)(p.ws + WS_Z);
    bf16_t* Qp = (bf16_t*)smem;
    bf16_t* Kp = Qp + 64 * 136;
    bf16_t* Qs = Kp + 64 * 136;
    bf16_t* Zi = Qs + 64 * 136;
    bf16_t* Zg = Zi + 64 * 136;
    bf16_t* VT = Zg + 64 * 136;
    bf16_t* Ab = VT + 128 * 72;
    float* tot = (float*)(Ab + 64 * 72);
    float* rss = tot + 512;
    const bf16_t* HS = (const bf16_t*)(p.ws + WS_HS) + (size_t)it * 16384;
    bf16x8 sf[4];
#pragma unroll
    for (int ks = 0; ks < 4; ++ks) sf[ks] = *(const bf16x8*)(HS + (size_t)(16 * w + fr) * 128 + ks * 32 + fq * 8);
    hg_stage(Qp, Z, tok0, nrows, ZHQ + h * 128, tid); hg_stage(Kp, Z, tok0, nrows, ZHF + h * 128, tid);
    hg_stage(Zi, Z, tok0, nrows, ZHI + h * 128, tid); hg_stage(Zg, Z, tok0, nrows, ZHG + h * 128, tid);
    __syncthreads();
    const int k = tid & 127, part = tid >> 7; const float lb = ((const float*)(p.ws + WS_LB))[l * 512 + h * 128 + k];
    float cs[16], kk[16], qv[16]; float run = 0.f;
    {   float vv[16];
#pragma unroll
        for (int i = 0; i < 16; ++i) { const int t = part * 16 + i;
            if (t < nrows) { const float sg = sigmoidf_(bf2f(Kp[t * 136 + k])); run += __logf(lb + (1.0f - lb) * sg + 1e-30f); kk[i] = (1.0f - lb) * (1.0f - sg); }
            else kk[i] = 0.f;
            qv[i] = bf2f(Qp[t * 136 + k]); vv[i] = bf2f(Zi[t * 136 + k]); cs[i] = run; }
        hg_store16(VT + k * 72 + part * 16, vv); }
    tot[part * 128 + k] = run;
    __syncthreads();
    float pre = 0.f; const float bmid = tot[k] + tot[128 + k];
#pragma unroll
    for (int q = 0; q < 4; ++q) if (q < part) pre += tot[q * 128 + k];
#pragma unroll
    for (int i = 0; i < 16; ++i) { const int t = part * 16 + i; const float bt = pre + cs[i];
        Qp[t * 136 + k] = f2bf(qv[i] * __expf(fminf(bt - bmid, 80.f))); Kp[t * 136 + k] = f2bf(kk[i] * __expf(fminf(bmid - bt, 80.f))); Qs[t * 136 + k] = f2bf(qv[i] * __expf(bt)); }
    __syncthreads();
    {   const int tm = w >> 1;
#pragma unroll
        for (int q = 0; q < 2; ++q) { const int sn = (w & 1) * 2 + q; f32x4 acc = {0.f, 0.f, 0.f, 0.f};
            if (sn <= tm) {
#pragma unroll
                for (int ks = 0; ks < 4; ++ks) { const bf16x8 a = *(const bf16x8*)(Qp + (16 * tm + fr) * 136 + ks * 32 + fq * 8), bb = *(const bf16x8*)(Kp + (16 * sn + fr) * 136 + ks * 32 + fq * 8); acc = mfma16(a, bb, acc); } }
#pragma unroll
            for (int j = 0; j < 4; ++j) { const int t = 16 * tm + 4 * fq + j, s2 = 16 * sn + fr; Ab[t * 72 + s2] = (s2 <= t && sn <= tm) ? f2bf(acc[j]) : (bf16_t)0; } }
    }
    __syncthreads();
    f32x4 o[4];
#pragma unroll
    for (int mt = 0; mt < 4; ++mt) o[mt] = (f32x4){0.f, 0.f, 0.f, 0.f};
#pragma unroll
    for (int ks = 0; ks < 2; ++ks) { const bf16x8 vf = *(const bf16x8*)(VT + (16 * w + fr) * 72 + ks * 32 + fq * 8);
#pragma unroll
        for (int mt = 0; mt < 4; ++mt) { const bf16x8 a = *(const bf16x8*)(Ab + (16 * mt + fr) * 72 + ks * 32 + fq * 8); o[mt] = mfma16(a, vf, o[mt]); } }
#pragma unroll
    for (int ks = 0; ks < 4; ++ks) {
#pragma unroll
        for (int mt = 0; mt < 4; ++mt) { const bf16x8 a = *(const bf16x8*)(Qs + (16 * mt + fr) * 136 + ks * 32 + fq * 8); o[mt] = mfma16(a, sf[ks], o[mt]); } }
#pragma unroll
    for (int mt = 0; mt < 4; ++mt)
#pragma unroll
        for (int j = 0; j < 4; ++j) { const float s2 = row16_sum(o[mt][j] * o[mt][j]);
            if (fr == 0) rss[(16 * mt + 4 * fq + j) * 8 + w] = s2; }
    __syncthreads();
    const float gn = p.in[14][l * 512 + h * 128 + 16 * w + fr];
#pragma unroll
    for (int mt = 0; mt < 4; ++mt)
#pragma unroll
        for (int j = 0; j < 4; ++j) { const int t = 16 * mt + 4 * fq + j;
            const f32x4 r0 = *(const f32x4*)(rss + t * 8), r1 = *(const f32x4*)(rss + t * 8 + 4);
            const float rs = rsqrtf((r0[0] + r0[1] + r0[2] + r0[3] + r1[0] + r1[1] + r1[2] + r1[3]) * (1.0f / 128.0f) + EPS);
            const float hg = bf2f(Zg[t * 136 + 16 * w + fr]);
            Qs[t * 136 + 16 * w + fr] = f2bf(o[mt][j] * rs * gn * hg * sigmoidf_(hg)); }
    __syncthreads();
    bf16_t* OC = (bf16_t*)(p.ws + WS_OCAT);
#pragma unroll
    for (int i = 0; i < 2; ++i) { const int c = tid + 512 * i, row = c >> 4, seg = c & 15;
        if (row < nrows) *(uint4*)(OC + (size_t)(tok0 + row) * 1536 + 512 + h * 128 + seg * 8) = *(const uint4*)(Qs + row * 136 + seg * 8); }
    __syncthreads();
}

__device__ __forceinline__ void cmlp_item(unsigned char* smem, const Params& p, int l, int item) {
    const int tid = opaque_tid(), lane = tid & 63, w = tid >> 6, fr = lane & 15, fq = lane >> 4;
    const int ch = item >> 2, g = item & 3; int tok0, nrows;
    if (ch < 128) { tok0 = ch * 128; nrows = 128; } else { tok0 = TP + (ch - 128) * DSEQ; nrows = 32; }
    const bf16_t* Z = (const bf16_t*)(p.ws + WS_Z);
    bf16_t* Vr = (bf16_t*)smem;
    bf16_t* VcT = Vr + 128 * 136;
    bf16_t* Wl = VcT + 128 * 136;
#pragma unroll
    for (int q = 0; q < 4; ++q) { const int c = tid + 512 * q, row = c >> 4, seg = c & 15; uint4 v = make_uint4(0, 0, 0, 0);
        if (row < nrows) v = *(const uint4*)(Z + (size_t)(tok0 + row) * NZ + ZCV + g * 128 + seg * 8);
        *(uint4*)(Vr + row * 136 + seg * 8) = v; }
    {   const int i = tid >> 2, j0 = (tid & 3) * 32; const float* wp = p.in[17] + ((size_t)(l * 4 + g) * 128 + i) * 128 + j0;
#pragma unroll
        for (int q = 0; q < 4; ++q) { f32x4 a = *(const f32x4*)(wp + q * 8), bb = *(const f32x4*)(wp + q * 8 + 4);
#pragma unroll
            for (int e = 0; e < 4; ++e) { if (j0 + q * 8 + e > i) a[e] = 0.f; if (j0 + q * 8 + 4 + e > i) bb[e] = 0.f; }
            *(uint4*)(Wl + i * 136 + j0 + q * 8) = pack8(a, bb); } }
    __syncthreads();
    {   const int c = tid & 127, part = tid >> 7;
#pragma unroll
        for (int q = 0; q < 4; ++q) { unsigned short e[8];
#pragma unroll
            for (int i = 0; i < 8; ++i) e[i] = Vr[(part * 32 + q * 8 + i) * 136 + c];
            uint4 o; o.x = e[0] | ((unsigned)e[1] << 16); o.y = e[2] | ((unsigned)e[3] << 16); o.z = e[4] | ((unsigned)e[5] << 16); o.w = e[6] | ((unsigned)e[7] << 16);
            *(uint4*)(VcT + c * 136 + part * 32 + q * 8) = o; } }
    __syncthreads();
    uint4 ur[4];
#pragma unroll
    for (int q = 0; q < 4; ++q) { const int c = tid + 512 * q, row = c >> 4, seg = c & 15; ur[q] = make_uint4(0, 0, 0, 0);
        if (row < nrows) ur[q] = *(const uint4*)(Z + (size_t)(tok0 + row) * NZ + ZCU + g * 128 + seg * 8); }
    const bool act = 16 * w < nrows;
    f32x4 acc[8];
    if (act) {
        bf16x8 af[4];
#pragma unroll
        for (int ks = 0; ks < 4; ++ks) af[ks] = *(const bf16x8*)(Wl + (16 * w + fr) * 136 + ks * 32 + fq * 8);
#pragma unroll
        for (int nt = 0; nt < 8; ++nt) { acc[nt] = (f32x4){0.f, 0.f, 0.f, 0.f};
#pragma unroll
            for (int ks = 0; ks < 4; ++ks) { const bf16x8 bb = *(const bf16x8*)(VcT + (16 * nt + fr) * 136 + ks * 32 + fq * 8); acc[nt] = mfma16(af[ks], bb, acc[nt]); } }
    }
#pragma unroll
    for (int q = 0; q < 4; ++q) { const int c = tid + 512 * q, row = c >> 4, seg = c & 15; *(uint4*)(Vr + row * 136 + seg * 8) = ur[q]; }
    __syncthreads();
    if (act) {
        float bias[4];
#pragma unroll
        for (int j = 0; j < 4; ++j) bias[j] = p.in[18][(size_t)(l * 4 + g) * 128 + 16 * w + 4 * fq + j];
#pragma unroll
        for (int nt = 0; nt < 8; ++nt)
#pragma unroll
            for (int j = 0; j < 4; ++j) { bf16_t* e = Vr + (16 * w + 4 * fq + j) * 136 + 16 * nt + fr; *e = f2bf(bf2f(*e) * (acc[nt][j] + bias[j])); }
    }
    __syncthreads();
    bf16_t* OC = (bf16_t*)(p.ws + WS_OCAT);
#pragma unroll
    for (int q = 0; q < 4; ++q) { const int c = tid + 512 * q, row = c >> 4, seg = c & 15;
        if (row < nrows) *(uint4*)(OC + (size_t)(tok0 + row) * 1536 + 1024 + g * 128 + seg * 8) = *(const uint4*)(Vr + row * 136 + seg * 8); }
    __syncthreads();
}

typedef unsigned u32x4 __attribute__((ext_vector_type(4)));
typedef unsigned u32x2 __attribute__((ext_vector_type(2)));
__device__ __forceinline__ void attn_item(unsigned char* smem, const Params& p, int item) {
    const int tid = opaque_tid(), lane = tid & 63, w = tid >> 6, fr = lane & 15, fq = lane >> 4;
    const bf16_t* Qb = (const bf16_t*)(p.ws + WS_Q);
    const int x = item - 64, i = 7 - (x >> 6), bh = x & 63, b = bh >> 3, h = bh & 7;
    const int qtok0 = b * SEQ + i * 256, nks = 2 * i + 2, wlim = 4 * i + (w >> 1) + 1;
    const bf16_t* kn = (const bf16_t*)(p.ws + WS_KN) + (size_t)b * SEQ * 512 + h * 64; const bf16_t* kr = (const bf16_t*)(p.ws + WS_KRB) + (size_t)b * SEQ * 32;
    const bf16_t* vt = (const bf16_t*)(p.ws + WS_VT) + (size_t)(b * 512 + h * 64) * SEQ;
    LAS unsigned char* L = (LAS unsigned char*)smem;
    constexpr int KSB = 128 * 208, VSB = 64 * 272, BUFB = KSB + VSB;
    bf16x8 qf[2][3];
#pragma unroll
    for (int qt = 0; qt < 2; ++qt) { const bf16_t* qp = Qb + (size_t)(qtok0 + 32 * w + 16 * qt + fr) * 768 + h * 96;
#pragma unroll
        for (int ks = 0; ks < 3; ++ks) qf[qt][ks] = *(const bf16x8*)(qp + ks * 32 + fq * 8); }
    f32x4 o[2][4]; float mrow[2], lrow[2];
#pragma unroll
    for (int qt = 0; qt < 2; ++qt) { mrow[qt] = -1e30f; lrow[qt] = 0.f;
#pragma unroll
        for (int d = 0; d < 4; ++d) o[qt][d] = (f32x4){0.f, 0.f, 0.f, 0.f}; }
    u32x4 rk0, rk1, rr, rv0, rv1;
    const int kr0 = tid >> 3, ksg = tid & 7, rrw = tid >> 2, rsg = tid & 3, vr0 = tid >> 4, vsg = tid & 15;
    const unsigned wk0 = kr0 * 208 + ksg * 16, wk1 = (kr0 + 64) * 208 + ksg * 16, wrr = rrw * 208 + 128 + rsg * 16, wv0 = KSB + vr0 * 272 + vsg * 16, wv1 = KSB + (vr0 + 32) * 272 + vsg * 16;
#define ATT_LOAD(k0) do { rk0 = *(const u32x4*)(kn + (size_t)((k0) + kr0) * 512 + ksg * 8); rk1 = *(const u32x4*)(kn + (size_t)((k0) + kr0 + 64) * 512 + ksg * 8); \
        rr = *(const u32x4*)(kr + (size_t)((k0) + rrw) * 32 + rsg * 8); rv0 = *(const u32x4*)(vt + (size_t)vr0 * SEQ + (k0) + vsg * 8); rv1 = *(const u32x4*)(vt + (size_t)(vr0 + 32) * SEQ + (k0) + vsg * 8); } while (0)
#define ATT_STORE(buf) do { LAS unsigned char* B_ = L + (buf) * BUFB; *(LAS u32x4*)(B_ + wk0) = rk0; *(LAS u32x4*)(B_ + wk1) = rk1; *(LAS u32x4*)(B_ + wrr) = rr; *(LAS u32x4*)(B_ + wv0) = rv0; *(LAS u32x4*)(B_ + wv1) = rv1; } while (0)
    ATT_LOAD(0); ATT_STORE(0);
    __syncthreads();
    if (nks > 1) ATT_LOAD(128);
    if (__builtin_amdgcn_readfirstlane(tid) >= 256) __builtin_amdgcn_s_setprio(1);
    for (int ks2 = 0; ks2 < nks; ++ks2) {
        if (ks2 + 1 < nks) ATT_STORE((ks2 + 1) & 1);
        if (ks2 + 2 < nks) ATT_LOAD((ks2 + 2) * 128);
        if (2 * ks2 < wlim) {
            const LAS unsigned char* KB = L + (ks2 & 1) * BUFB; const LAS unsigned char* VB = KB + KSB;
            f32x4 s[2][8];
#pragma unroll
            for (int nt = 0; nt < 8; ++nt) { s[0][nt] = (f32x4){0.f, 0.f, 0.f, 0.f}; s[1][nt] = (f32x4){0.f, 0.f, 0.f, 0.f};
#pragma unroll
                for (int ks = 0; ks < 3; ++ks) { const bf16x8 kf = *(const LAS bf16x8*)(KB + (16 * nt + fr) * 208 + ks * 64 + fq * 16);
                    s[0][nt] = mfma16(kf, qf[0][ks], s[0][nt]); s[1][nt] = mfma16(kf, qf[1][ks], s[1][nt]); } }
            if (2 * ks2 + 1 >= wlim) {
#pragma unroll
                for (int nt = 4; nt < 8; ++nt) { s[0][nt] = (f32x4){-1e30f, -1e30f, -1e30f, -1e30f}; s[1][nt] = (f32x4){-1e30f, -1e30f, -1e30f, -1e30f}; } }
            bf16x8 pb[2][4];
#pragma unroll
            for (int qt = 0; qt < 2; ++qt) {
                float mx = -1e30f;
#pragma unroll
                for (int nt = 0; nt < 8; ++nt) mx = fmaxf(mx, fmaxf(fmaxf(s[qt][nt][0], s[qt][nt][1]), fmaxf(s[qt][nt][2], s[qt][nt][3])));
                mx = xr32_max(xr16_max(mx));
                float mn = mrow[qt], al = 1.0f;
                if (__builtin_amdgcn_ballot_w64(mx - mn > 8.0f) != 0ull) { mn = fmaxf(mn, mx); al = __builtin_amdgcn_exp2f(mrow[qt] - mn); mrow[qt] = mn;
#pragma unroll
                    for (int dn = 0; dn < 4; ++dn) o[qt][dn] = o[qt][dn] * al; }
                float ps = 0.f;
#pragma unroll
                for (int nt = 0; nt < 8; ++nt)
#pragma unroll
                    for (int j = 0; j < 4; ++j) { const float pv = __builtin_amdgcn_exp2f(s[qt][nt][j] - mn); s[qt][nt][j] = pv; ps += pv; }
                lrow[qt] = lrow[qt] * al + ps;
#pragma unroll
                for (int t = 0; t < 4; ++t) { const u32x4 u = {pk2(s[qt][2 * t][0], s[qt][2 * t][1]), pk2(s[qt][2 * t][2], s[qt][2 * t][3]), pk2(s[qt][2 * t + 1][0], s[qt][2 * t + 1][1]), pk2(s[qt][2 * t + 1][2], s[qt][2 * t + 1][3])};
                    pb[qt][t] = __builtin_bit_cast(bf16x8, u); }
            }
#pragma unroll
            for (int t = 0; t < 4; ++t)
#pragma unroll
                for (int dn = 0; dn < 4; ++dn) { const LAS unsigned char* vp = VB + (16 * dn + fr) * 272 + (32 * t + 4 * fq) * 2;
                    const u32x2 v0 = *(const LAS u32x2*)vp, v1 = *(const LAS u32x2*)(vp + 32); const u32x4 u = {v0[0], v0[1], v1[0], v1[1]}; const bf16x8 vf = __builtin_bit_cast(bf16x8, u);
                    o[0][dn] = mfma16(vf, pb[0][t], o[0][dn]); o[1][dn] = mfma16(vf, pb[1][t], o[1][dn]); }
        }
        __syncthreads();
    }
#undef ATT_LOAD
#undef ATT_STORE
    __builtin_amdgcn_s_setprio(0);
    bf16_t* OC = (bf16_t*)(p.ws + WS_OCAT);
#pragma unroll
    for (int qt = 0; qt < 2; ++qt) { float ls = lrow[qt]; ls = xr32_sum(xr16_sum(ls)); const float inv = 1.0f / ls; const int r = 32 * w + 16 * qt + fr;
#pragma unroll
        for (int dn = 0; dn < 4; ++dn) { const f32x4 v = o[qt][dn] * inv; *(uint2*)(OC + (size_t)(qtok0 + r) * 1536 + h * 64 + 16 * dn + 4 * fq) = make_uint2(pk2(v[0], v[1]), pk2(v[2], v[3])); } }
}

__device__ __forceinline__ void attn_sample_item(unsigned char* smem, const Params& p, int item) {
    const int tid = opaque_tid(), lane = tid & 63, w = tid >> 6, fr = lane & 15, fq = lane >> 4;
    const int b = item >> 3, h = item & 7, qtok0 = TP + b * DSEQ;
    const bf16_t* kn = (const bf16_t*)(p.ws + WS_KNS) + (size_t)b * KSS * 512 + h * 64; const bf16_t* kr = (const bf16_t*)(p.ws + WS_KRS) + (size_t)b * KSS * 32;
    const bf16_t* vt = (const bf16_t*)(p.ws + WS_VTS) + (size_t)(b * 512 + h * 64) * KSS; const bf16_t* Qb = (const bf16_t*)(p.ws + WS_Q);
    bf16x8 qf[2][3];
#pragma unroll
    for (int qt = 0; qt < 2; ++qt) { const bf16_t* qp = Qb + (size_t)(qtok0 + 16 * qt + fr) * 768 + h * 96;
#pragma unroll
        for (int ks = 0; ks < 3; ++ks) qf[qt][ks] = *(const bf16x8*)(qp + ks * 32 + fq * 8); }
    f32x4 o[2][4]; float mrow[2], lrow[2];
#pragma unroll
    for (int qt = 0; qt < 2; ++qt) { mrow[qt] = -1e30f; lrow[qt] = 0.f;
#pragma unroll
        for (int i = 0; i < 4; ++i) o[qt][i] = (f32x4){0.f, 0.f, 0.f, 0.f}; }
    for (int kt = w; kt < 65; kt += 8) {
        const int k0 = kt * 64;
        f32x4 s[2][4];
#pragma unroll
        for (int nt = 0; nt < 4; ++nt) { s[0][nt] = (f32x4){0.f, 0.f, 0.f, 0.f}; s[1][nt] = (f32x4){0.f, 0.f, 0.f, 0.f};
            const size_t key = (size_t)(k0 + 16 * nt + fr);
#pragma unroll
            for (int ks = 0; ks < 3; ++ks) { const bf16x8 kf = (ks < 2) ? *(const bf16x8*)(kn + key * 512 + ks * 32 + fq * 8) : *(const bf16x8*)(kr + key * 32 + fq * 8);
                s[0][nt] = mfma16(kf, qf[0][ks], s[0][nt]); s[1][nt] = mfma16(kf, qf[1][ks], s[1][nt]); } }
        if (kt == 64) {
#pragma unroll
            for (int nt = 0; nt < 4; ++nt)
#pragma unroll
                for (int j = 0; j < 4; ++j) if (k0 + 16 * nt + 4 * fq + j >= PAST + DSEQ) { s[0][nt][j] = -1e30f; s[1][nt][j] = -1e30f; } }
        bf16x8 pb[2][2];
#pragma unroll
        for (int qt = 0; qt < 2; ++qt) {
            float mx = -1e30f;
#pragma unroll
            for (int nt = 0; nt < 4; ++nt) mx = fmaxf(mx, fmaxf(fmaxf(s[qt][nt][0], s[qt][nt][1]), fmaxf(s[qt][nt][2], s[qt][nt][3])));
            mx = xr32_max(xr16_max(mx));
            float mn = mrow[qt], al = 1.0f;
            if (__builtin_amdgcn_ballot_w64(mx - mn > 8.0f) != 0ull) { mn = fmaxf(mn, mx); al = __builtin_amdgcn_exp2f(mrow[qt] - mn); mrow[qt] = mn;
#pragma unroll
                for (int dn = 0; dn < 4; ++dn) o[qt][dn] = o[qt][dn] * al; }
            float ps = 0.f;
#pragma unroll
            for (int nt = 0; nt < 4; ++nt)
#pragma unroll
                for (int j = 0; j < 4; ++j) { const float pv = __builtin_amdgcn_exp2f(s[qt][nt][j] - mn); s[qt][nt][j] = pv; ps += pv; }
            lrow[qt] = lrow[qt] * al + ps;
#pragma unroll
            for (int t = 0; t < 2; ++t) { const u32x4 u = {pk2(s[qt][2 * t][0], s[qt][2 * t][1]), pk2(s[qt][2 * t][2], s[qt][2 * t][3]), pk2(s[qt][2 * t + 1][0], s[qt][2 * t + 1][1]), pk2(s[qt][2 * t + 1][2], s[qt][2 * t + 1][3])};
                pb[qt][t] = __builtin_bit_cast(bf16x8, u); }
        }
#pragma unroll
        for (int t = 0; t < 2; ++t)
#pragma unroll
            for (int dn = 0; dn < 4; ++dn) { const bf16_t* vp = vt + (size_t)(16 * dn + fr) * KSS + k0 + 32 * t + 4 * fq;
                const u32x2 v0 = *(const u32x2*)vp, v1 = *(const u32x2*)(vp + 16); const u32x4 u = {v0[0], v0[1], v1[0], v1[1]}; const bf16x8 vf = __builtin_bit_cast(bf16x8, u);
                o[0][dn] = mfma16(vf, pb[0][t], o[0][dn]); o[1][dn] = mfma16(vf, pb[1][t], o[1][dn]); }
    }
    float* Ow = (float*)smem; float* Mw = Ow + 8 * 32 * 68; float* Lw = Mw + 256;
#pragma unroll
    for (int qt = 0; qt < 2; ++qt) { float ls = lrow[qt]; ls = xr32_sum(xr16_sum(ls));
        if (fq == 0) { Mw[w * 32 + 16 * qt + fr] = mrow[qt]; Lw[w * 32 + 16 * qt + fr] = ls; }
#pragma unroll
        for (int dn = 0; dn < 4; ++dn) *(f32x4*)(Ow + (size_t)(w * 32 + 16 * qt + fr) * 68 + 16 * dn + 4 * fq) = o[qt][dn]; }
    __syncthreads();
    {   const int q = tid >> 4, d0 = (tid & 15) * 4; float M = -1e30f;
#pragma unroll
        for (int ww = 0; ww < 8; ++ww) M = fmaxf(M, Mw[ww * 32 + q]);
        f32x4 acc = {0.f, 0.f, 0.f, 0.f}; float L = 0.f;
#pragma unroll
        for (int ww = 0; ww < 8; ++ww) { const float sc = __builtin_amdgcn_exp2f(Mw[ww * 32 + q] - M); L += sc * Lw[ww * 32 + q]; acc = acc + *(const f32x4*)(Ow + (size_t)(ww * 32 + q) * 68 + d0) * sc; }
        const float inv = 1.0f / L; acc = acc * inv;
        *(uint2*)((bf16_t*)(p.ws + WS_OCAT) + (size_t)(qtok0 + q) * 1536 + h * 64 + d0) = make_uint2(pk2(acc[0], acc[1]), pk2(acc[2], acc[3])); }
    __syncthreads();
}

#define XB_TMO      128
#define XB_XCNT(j)  (256  + 64 * (j))
#define XB_XSUB(j)  (1280 + 64 * (j))
#define XB_XGEN(j)  (2304 + 64 * (j))
#define XB_TOP      3328
#define XB_TOPGEN   3392
#define XB_SPIN_CAP (1u << 20)
__device__ __forceinline__ unsigned xb_ld(unsigned* p)              { return __hip_atomic_load(p, __ATOMIC_RELAXED, __HIP_MEMORY_SCOPE_AGENT); }
__device__ __forceinline__ unsigned xb_add(unsigned* p, unsigned v) { return __hip_atomic_fetch_add(p, v, __ATOMIC_RELAXED, __HIP_MEMORY_SCOPE_AGENT); }
__device__ __forceinline__ unsigned xb_xcc_id() { return (unsigned)__builtin_amdgcn_s_getreg((3 << 11) | 20) & 0xFu; }
#define XB_SPIN(cond, bar) do { unsigned _sp = 0; while (cond) { __builtin_amdgcn_s_sleep(1); \
    if ((++_sp & 255u) == 0u) { if (xb_ld(&(bar)[XB_TMO])) break; if (_sp > XB_SPIN_CAP) { atomicAdd(&(bar)[XB_TMO], 1u); break; } } } } while (0)
struct XcdBarrier { unsigned* bar; unsigned x; volatile LAS unsigned* st; };
__device__ __forceinline__ XcdBarrier xcd_barrier_post(unsigned* bar, volatile LAS unsigned* st) {
    XcdBarrier b; b.bar = bar; b.x = xb_xcc_id(); b.st = st;
    if (threadIdx.x == 0) (void)xb_add(&bar[XB_XCNT(b.x)], 1u);
    return b;
}
__device__ __forceinline__ void xcd_barrier_complete(unsigned* bar, unsigned x, unsigned& nloc, unsigned& nx) {
    const unsigned G = gridDim.x * gridDim.y * gridDim.z;
    unsigned sum, cnt, mine, sp = 0u;
    for (;;) {
        sum = 0u; cnt = 0u; mine = 0u;
#pragma unroll
        for (unsigned j = 0; j < 16; ++j) { const unsigned c = xb_ld(&bar[XB_XCNT(j)]); sum += c; cnt += (c > 0u) ? 1u : 0u; mine = (j == x) ? c : mine; }
        if (sum == G) break;
        __builtin_amdgcn_s_sleep(1);
        if ((++sp & 255u) == 0u) { if (xb_ld(&bar[XB_TMO])) break; if (sp > XB_SPIN_CAP) { atomicAdd(&bar[XB_TMO], 1u); break; } }
    }
    nloc = mine > 0u ? mine : 1u; nx = cnt > 0u ? cnt : 1u;
}
__device__ __forceinline__ void xcd_barrier(const XcdBarrier& b) {
    asm volatile("s_waitcnt vmcnt(0)" ::: "memory");
    __syncthreads();
    if (threadIdx.x == 0) {
        unsigned* bar = b.bar;
        __builtin_amdgcn_s_waitcnt(0);
        unsigned nloc = b.st[0], nx = b.st[1];
        if (nloc == 0u) { xcd_barrier_complete(bar, b.x, nloc, nx); b.st[0] = nloc; b.st[1] = nx; }
        const unsigned old = xb_add(&bar[XB_XSUB(b.x)], 1u);
        const unsigned gen = old / nloc;
        if (old + 1u == (gen + 1u) * nloc) {
            __builtin_amdgcn_fence(__ATOMIC_RELEASE, "agent");
            asm volatile("s_waitcnt vmcnt(0)" ::: "memory");
            const unsigned og = xb_add(&bar[XB_TOP], 1u);
            const unsigned tg = og / nx;
            if (og + 1u == (tg + 1u) * nx) xb_add(&bar[XB_TOPGEN], 1u);
            else XB_SPIN(xb_ld(&bar[XB_TOPGEN]) == tg, bar);
            __builtin_amdgcn_fence(__ATOMIC_ACQUIRE, "agent");
            xb_add(&bar[XB_XGEN(b.x)], 1u);
            asm volatile("s_waitcnt vmcnt(0)" ::: "memory");
        } else {
            XB_SPIN(xb_ld(&bar[XB_XGEN(b.x)]) == gen, bar);
            __builtin_amdgcn_fence(__ATOMIC_ACQUIRE, "agent");
            asm volatile("s_waitcnt vmcnt(0)" ::: "memory");
        }
    }
    __syncthreads();
}

__device__ __forceinline__ void prologue(unsigned char* smem, const Params& p) {
    const size_t gt = (size_t)blockIdx.x * 512 + opaque_tid();
    if (gt < 2080 * 16) { const int pidx = (int)(gt >> 4), i = (int)(gt & 15); const float pos = (float)(pidx < SEQ ? pidx : PAST + pidx - SEQ);
        const float inv = 1.0f / powf(10000.0f, (float)i / 16.0f); float sn, cs; sincosf(pos * inv, &sn, &cs);
        float* rp = (float*)(p.ws + WS_ROPE) + gt * 2; rp[0] = cs; rp[1] = sn; }
    if (gt < 512) { const float* hb = p.in[13]; const float a0 = hb[gt], a1 = hb[512 + gt], a2 = hb[1024 + gt], a3 = hb[1536 + gt]; const float mx = fmaxf(fmaxf(a0, a1), fmaxf(a2, a3));
        const float e0 = expf(a0 - mx), e1 = expf(a1 - mx), e2 = expf(a2 - mx), e3 = expf(a3 - mx), inv = 1.0f / (e0 + e1 + e2 + e3);
        float* lb = (float*)(p.ws + WS_LB); lb[gt] = 0.f; lb[512 + gt] = e1 * inv; lb[1024 + gt] = (e1 + e2) * inv; lb[1536 + gt] = (e1 + e2 + e3) * inv; }
    ln_rows(p.in[0], p.in[1], p.out + O_YP, (bf16_t*)(p.ws + WS_XB), p.in[5], p.in[6], nullptr, true);
    conv_layer(smem, p, 0);
}

template <int KSEL> __device__ __forceinline__ void run_phase(unsigned char* smem, const Params& p, int ph) {
    if (ph == 0) { if (KSEL < 0 || KSEL == 10) prologue(smem, p); return; }
    const int rep = ph >= 1000 ? 1 : 0; ph = ph % 1000; const int l = (ph - 1) / 10, k = (KSEL >= 20) ? 2 : (KSEL >= 0 && KSEL < 10) ? KSEL : (ph - 1) % 10;
    if (KSEL == 10) return;
    const bf16_t* W = (const bf16_t*)(p.ws + WS_WT);
    bf16_t* Z = (bf16_t*)(p.ws + WS_Z); bf16_t* XB = (bf16_t*)(p.ws + WS_XB); bf16_t* OC = (bf16_t*)(p.ws + WS_OCAT);
    float* X = p.out + O_YP; float* ST = (float*)(p.ws + WS_ST);
    const int G = gridDim.x, bid = blockIdx.x;
    switch (k) {
    case 0: { EpiZ e; e.Z = Z; run_gemm(smem, XB, 1024, W + W_IN, 1024, TT, NZ, 1024, 0, e); } break;
    case 1: {
        rowops(p, l); cache_conv(p, l);
        for (int it = bid; it < 1056; it += G) hgrn_pass1(smem, p, l, it);
    } break;
    case 2: {
        if (KSEL < 20 || KSEL == 20) { EpiQ e; e.Q = (bf16_t*)(p.ws + WS_Q); e.rope = (const float*)(p.ws + WS_ROPE); run_gemm(smem, Z + ZCQ, NZ, W + W_UQ, 256, TT, 768, 256, 0, e); }
        {   EpiKV4 e; e.kn0.KN = (bf16_t*)(p.ws + WS_KN); e.kn0.KNS = (bf16_t*)(p.ws + WS_KNS); e.kn0.mode = 0; e.kn1.KN = nullptr; e.kn1.KNS = e.kn0.KNS; e.kn1.mode = 1;
            e.vt0.VT = (bf16_t*)(p.ws + WS_VT); e.vt0.VTS = (bf16_t*)(p.ws + WS_VTS); e.vt0.mode = 0; e.vt1.VT = nullptr; e.vt1.VTS = e.vt0.VTS; e.vt1.mode = 1;
            int Kop = 256; asm volatile("" : "+s"(Kop));
            pg8::Gemm g; g.A = (const bf16_t*)p.ws; g.Bt = (const bf16_t*)p.ws; g.M = 0; g.N = 0; g.K = Kop; g.lda = 256; g.ldb = 256;
            const long oW = (long)(WS_WT + W_UKV * 2), oWv = oW + 512 * 256 * 2, oC = (long)WS_CKVN, oX = (long)WS_XB;
            KV4Order S; S.G = G; S.c = bid; S.oW = oW; S.oWv = oWv; S.oC = oC; S.oX = oX;
            pg8::gemm_phase<EpiKV4, KV4Order>((LAS unsigned char*)smem, g, S, e);
            __syncthreads(); }
        if (KSEL < 20 || KSEL == 25) for (int it = bid; it < 544; it += G) cmlp_item(smem, p, l, it);
#ifndef NO_SCAN
        if (KSEL < 20 || KSEL == 25) for (int it = bid; it < 1024; it += G) hgrn_scan(p, l, it);
#endif
    } break;
    case 3: {
        unsigned* ctr = (unsigned*)(p.ws + WS_CTL) + l; int* sitem = (int*)(smem + LDS_BYTES - 16);
        int nxt = 0; if (threadIdx.x == 0) nxt = (int)atomicAdd(ctr, 1u);
        for (;;) {
            if (threadIdx.x == 0) *sitem = nxt;
            __syncthreads(); const int it = *sitem;
            if (it >= 576 + 1056) break;
            if (threadIdx.x == 0) nxt = (int)atomicAdd(ctr, 1u);
            if (it < 64) attn_sample_item(smem, p, it); else if (it < 576) attn_item(smem, p, it); else hgrn_pass3(smem, p, l, it - 576);
        }
    } break;
    case 4: { EpiMerge e; e.Mo = XB; e.Z = Z; run_gemm(smem, OC, 1536, W + W_CAT, 1536, TP, 1024, 1536, 0, e); skinny_gemm<3, 1>(smem, p, OC, 1536, W + W_CAT, 1536, 512); } break;
    case 5: { EpiRes e; e.X = X; e.ST = l ? ST : nullptr; e.G = p.in[27] + (l ? l - 1 : 0) * 1024; e.B = p.in[28] + (l ? l - 1 : 0) * 1024; run_gemm(smem, XB, 1024, W + W_O, 1024, TP, 1024, 1024, 0, e); skinny_gemm<1, 0>(smem, p, XB, 1024, W + W_O, 1024, 1024, e.ST, e.G, e.B); } break;
    case 6: ln_rows(X, X + (size_t)TP * 1024, X, XB, p.in[23] + l * 1024, p.in[24] + l * 1024, ST, false); break;
    case 7: { EpiUp e; e.H = Z; run_gemm(smem, XB, 1024, W + W_UP, 1024, TT, 5632, 1024, 0, e); } break;
    case 8: { EpiRes e; e.X = X; e.ST = ST; e.G = p.in[23] + l * 1024; e.B = p.in[24] + l * 1024; run_gemm(smem, Z, DFF, W + W_DN, DFF, TP, 1024, DFF, 0, e); skinny_gemm<1, 0>(smem, p, Z, DFF, W + W_DN, DFF, DFF, e.ST, e.G, e.B); } break;
    case 9: { ln_rows(X, X + (size_t)TP * 1024, X, XB, p.in[27] + l * 1024, p.in[28] + l * 1024, ST, l + 1 == DEPTH); if (l + 1 < DEPTH) conv_layer(smem, p, l + 1); } break;
    }
}

__global__ void __launch_bounds__(512, 2) fwd_megakernel(Params p) {
    extern __shared__ __attribute__((aligned(16))) unsigned char shm[];
    volatile LAS unsigned* st = (volatile LAS unsigned*)(LAS unsigned char*)(shm + LDS_BYTES - 32);
    if (threadIdx.x == 0) { st[0] = 0u; st[1] = 0u; }
    __syncthreads();
    const XcdBarrier xb = xcd_barrier_post((unsigned*)(p.ws + WS_BAR), st);
    for (int ph = p.ph_lo; ph < p.ph_hi; ++ph) {
        run_phase<-1>(shm, p, ph);
        if (ph + 1 < p.ph_hi) { if (p.ph_lo < 0) cg::this_grid().sync();
            xcd_barrier(xb); }
    }
}
#ifdef TESTK
template <int KS> __global__ void __launch_bounds__(512, 2) test_k(Params p) { extern __shared__ __attribute__((aligned(16))) unsigned char shm[]; run_phase<KS>(shm, p, p.ph_lo); }
template __global__ void test_k<0>(Params); template __global__ void test_k<1>(Params); template __global__ void test_k<2>(Params); template __global__ void test_k<3>(Params);
template __global__ void test_k<4>(Params); template __global__ void test_k<5>(Params); template __global__ void test_k<6>(Params); template __global__ void test_k<7>(Params);
template __global__ void test_k<8>(Params); template __global__ void test_k<9>(Params); template __global__ void test_k<10>(Params); template __global__ void test_k<20>(Params); template __global__ void test_k<21>(Params); template __global__ void test_k<22>(Params); template __global__ void test_k<23>(Params); template __global__ void test_k<24>(Params); template __global__ void test_k<25>(Params);
#endif
extern "C" void kernel_launch(void* const* d_in, const int* in_sizes, int n_in, void* d_out, int out_size, void* d_ws, size_t ws_size, hipStream_t stream) {
    static int grid = 0;
    if (grid == 0) {
        int dev = 0, cus = 0, per_cu = 0;
        hipGetDevice(&dev); hipDeviceGetAttribute(&cus, hipDeviceAttributeMultiprocessorCount, dev);
        hipFuncSetAttribute((const void*)fwd_megakernel, hipFuncAttributeMaxDynamicSharedMemorySize, LDS_BYTES);
        hipOccupancyMaxActiveBlocksPerMultiprocessor(&per_cu, (const void*)fwd_megakernel, 512, LDS_BYTES);
        (void)hipGetLastError();
        if (per_cu < 1) per_cu = 1;
        grid = cus;
        if (ws_size < WS_END) { fprintf(stderr, "kernel_launch: workspace too small: %zu < %zu\n", ws_size, (size_t)WS_END); grid = -1; }
    }
    if (grid < 0) return;
    (void)hipMemsetAsync((char*)d_ws + WS_CTL, 0, 32768, stream);
    Params p{};
    for (int i = 0; i < 29; ++i) p.in[i] = (const float*)d_in[i];
    p.out = (float*)d_out; p.ws = (unsigned char*)d_ws;
#ifndef NPH_RUN
#define NPH_RUN (1 + 10 * DEPTH)
#endif
    const int NPH = NPH_RUN;
#if ONE_LAUNCH
    p.ph_lo = 0; p.ph_hi = NPH;
    void* args[] = {&p};
    hipError_t e = hipLaunchCooperativeKernel((const void*)fwd_megakernel, dim3(grid), dim3(512), args, LDS_BYTES, stream);
    if (e != hipSuccess) fprintf(stderr, "cooperative launch failed: %s (grid %d)\n", hipGetErrorString(e), grid);
#else
    for (int ph = 0; ph < NPH; ++ph) { p.ph_lo = ph; p.ph_hi = ph + 1; hipLaunchKernelGGL(fwd_megakernel, dim3(grid), dim3(512), LDS_BYTES, stream, p); }
#endif
}
```

```cpp
#include <hip/hip_runtime.h>
#include <hip/hip_cooperative_groups.h>
#include <stdint.h>
#include <stdio.h>
namespace cg = cooperative_groups;

#ifndef ONE_LAUNCH
#define ONE_LAUNCH 1
#endif

typedef unsigned short bf16_t;
typedef short bf16x8 __attribute__((ext_vector_type(8)));
typedef float f32x4 __attribute__((ext_vector_type(4)));
typedef float f32x2 __attribute__((ext_vector_type(2)));
#define LAS __attribute__((address_space(3)))

constexpr int DM = 1024, TP = 16384, TS = 256, TT = TP + TS, DEPTH = 4, NZ = 6912;
constexpr int SEQ = 2048, DSEQ = 32, PAST = 4096, KSS = 4160;
constexpr int DFF = 2816;
constexpr int ZCQ = 0, ZCKV = 256, ZHQ = 512, ZHF = 1024, ZHI = 1536, ZHG = 2048, ZCU = 2560, ZCV = 3072, ZGA = 3584, ZGB = 4608, ZGC = 5632, ZKR = 6656;
constexpr float EPS = 1e-5f;
constexpr float ALPHA = 1.681792830507429f;
constexpr float QSCALE = 0.10206207261596577f * 1.4426950408889634f;
constexpr size_t O_YP = 0, O_YS = 16777216, O_CKVP = 17039360, O_KRP = 33816576, O_HSP = 35913728, O_CKVS = 38010880, O_KRS = 38273024, O_HSS = 38305792, O_VS = 40402944;
constexpr size_t W_IN = 0, W_UQ = W_IN + (size_t)NZ * 1024, W_UKV = W_UQ + 768 * 256, W_CAT = W_UKV + 1024 * 256, W_O = W_CAT + 1024 * 1536, W_UP = W_O + 1024 * 1024,
                 W_DN = W_UP + (size_t)5632 * 1024, W_END = W_DN + (size_t)1024 * DFF;
constexpr size_t al(size_t x) { return (x + 255) & ~(size_t)255; }
constexpr size_t WS_CTL = 0, WS_BAR = 4096, WS_ROPE = 32768, WS_LB = al(WS_ROPE + 2080 * 16 * 8), WS_WT = al(WS_LB + 4 * 512 * 4), WS_XB = al(WS_WT + W_END * 2),
                 WS_Z = al(WS_XB + (size_t)TT * 1024 * 2), WS_Q = al(WS_Z + (size_t)TT * NZ * 2), WS_KN = al(WS_Q + (size_t)TT * 768 * 2), WS_VT = al(WS_KN + (size_t)TP * 512 * 2),
                 WS_KRB = al(WS_VT + (size_t)TP * 512 * 2), WS_KNS = al(WS_KRB + (size_t)TP * 32 * 2), WS_VTS = al(WS_KNS + (size_t)8 * KSS * 512 * 2),
                 WS_KRS = al(WS_VTS + (size_t)8 * 512 * KSS * 2), WS_OCAT = al(WS_KRS + (size_t)8 * KSS * 32 * 2), WS_HS = al(WS_OCAT + (size_t)TT * 1536 * 2),
                 WS_HD = al(WS_HS + (size_t)1056 * 16384 * 2), WS_ST = al(WS_HD + (size_t)1056 * 128 * 4), WS_CKVN = al(WS_ST + (size_t)TT * 2 * 4), WS_END = al(WS_CKVN + (size_t)TT * 256 * 2);
constexpr int LDS_BYTES = 144 * 1024;

struct Params { const float* in[29]; float* out; unsigned char* ws; int ph_lo, ph_hi; };

typedef unsigned nt_u4 __attribute__((ext_vector_type(4)));
__device__ __forceinline__ void stnt4(void* p, uint4 v) { const nt_u4 t = {v.x, v.y, v.z, v.w}; __builtin_nontemporal_store(t, (nt_u4*)p); }
__device__ __forceinline__ float bf2f(bf16_t b) { return __uint_as_float(((unsigned)b) << 16); }
typedef __bf16 bf16x2_t __attribute__((ext_vector_type(2)));
__device__ __forceinline__ unsigned pk2(float lo, float hi) { f32x2 v = {lo, hi}; bf16x2_t b = __builtin_convertvector(v, bf16x2_t); return __builtin_bit_cast(unsigned, b); }
__device__ __forceinline__ bf16_t f2bf(float f) { return (bf16_t)(pk2(f, 0.f) & 0xffffu); }
__device__ __forceinline__ float lo16(unsigned u) { return __uint_as_float(u << 16); }
__device__ __forceinline__ float hi16(unsigned u) { return __uint_as_float(u & 0xffff0000u); }
__device__ __forceinline__ int opaque_tid() { int t = threadIdx.x; asm volatile("" : "+v"(t)); return t; }
template <int CTRL> __device__ __forceinline__ float dpp_f(float v) { return __int_as_float(__builtin_amdgcn_update_dpp(0, __float_as_int(v), CTRL, 0xF, 0xF, true)); }
__device__ __forceinline__ float row16_sum(float v) { v += dpp_f<0xB1>(v); v += dpp_f<0x4E>(v); v += dpp_f<0x141>(v); v += dpp_f<0x140>(v); return v; }
__device__ __forceinline__ float rl_f(float v, int lane) { return __int_as_float(__builtin_amdgcn_readlane(__float_as_int(v), lane)); }
__device__ __forceinline__ float wave_sum(float v) { v = row16_sum(v); return (rl_f(v, 0) + rl_f(v, 16)) + (rl_f(v, 32) + rl_f(v, 48)); }
__device__ __forceinline__ float xr16_max(float x) { const auto r = __builtin_amdgcn_permlane16_swap(__float_as_uint(x), __float_as_uint(x), false, false); return fmaxf(__uint_as_float(r[0]), __uint_as_float(r[1])); }
__device__ __forceinline__ float xr32_max(float x) { const auto r = __builtin_amdgcn_permlane32_swap(__float_as_uint(x), __float_as_uint(x), false, false); return fmaxf(__uint_as_float(r[0]), __uint_as_float(r[1])); }
__device__ __forceinline__ float xr16_sum(float x) { const auto r = __builtin_amdgcn_permlane16_swap(__float_as_uint(x), __float_as_uint(x), false, false); return __uint_as_float(r[0]) + __uint_as_float(r[1]); }
__device__ __forceinline__ float xr32_sum(float x) { const auto r = __builtin_amdgcn_permlane32_swap(__float_as_uint(x), __float_as_uint(x), false, false); return __uint_as_float(r[0]) + __uint_as_float(r[1]); }
__device__ __forceinline__ float sigmoidf_(float x) { return __builtin_amdgcn_rcpf(1.0f + __builtin_amdgcn_exp2f(-1.4426950408889634f * x)); }
__device__ __forceinline__ float gelu_exact(float v) {
    const float av = fabsf(v), t = __builtin_amdgcn_rcpf(av * 0.2316418882f + 1.0f);
    float q = t * 0.5307027145f + (-0.7265760135f); q = q * t + 0.7107068705f; q = q * t + (-0.142248368f); q = q * t + 0.127414796f; q = q * t;
    const float e = __builtin_amdgcn_exp2f((v * v) * (-0.72134752044f));
    const float m = v * (q * e); return v < 0.f ? m : v - m;
}
__device__ __forceinline__ f32x4 mfma16(bf16x8 a, bf16x8 b, f32x4 c) { return __builtin_amdgcn_mfma_f32_16x16x32_bf16(a, b, c, 0, 0, 0); }

namespace pg8 {
constexpr int BM = 256, BK = 64, HALF = 128, HTB = HALF * BK * 2, STAGE_BYTES = 8 * HTB, NXCD = 8, WGM = 8;
__host__ __device__ __forceinline__ int lds_byte(int r, int c) { const int st = (r >> 4) * 2 + (c >> 5), rr = r & 15, cc = c & 31, ob = rr * 64 + cc * 2; return st * 1024 + (ob ^ (((ob >> 9) & 1) << 5)); }
__host__ __device__ __forceinline__ void stage_rc(int b, int& R, int& C) { const int st = b / 1024, sb = b % 1024, swz = sb ^ (((sb >> 9) & 1) << 5); R = (st >> 1) * 16 + swz / 64; C = (st & 1) * 32 + (swz % 64) / 2; }
__host__ __device__ __forceinline__ int perm32(int rho) { const int n = rho >> 4, i = rho & 15; return 8 * (i >> 2) + 4 * n + (i & 3); }
struct Unit { int pm, pn, g; long ao, bo; };
struct Gemm { const bf16_t* A; const bf16_t* Bt; int M, N, K, lda, ldb; };
struct StaticOrder {
    int nM, nN, nwg, G, c;
    __device__ void init(int M, int N, int G_, int c_) { nM = M / BM; nN = N / BM; nwg = nM * nN; G = G_; c = c_; }
    __device__ bool next(int i, Unit& u) const {
        const long L = (long)i * G + c; if (L >= nwg) return false;
        int wgid = (int)L; { const int q = nwg / NXCD, r = nwg % NXCD, xcd = wgid % NXCD, off = wgid / NXCD; wgid = (xcd < r ? xcd * (q + 1) : r * (q + 1) + (xcd - r) * q) + off; }
        const int nig = WGM * nN, gid = wgid / nig, fm = gid * WGM, gsz = (nM - fm) < WGM ? (nM - fm) : WGM;
        u.pm = fm + ((wgid % nig) % gsz); u.pn = (wgid % nig) / gsz; u.g = 0; u.ao = 0; u.bo = 0; return true;
    }
};

template <class Epi, class Order>
__device__ __forceinline__ void gemm_phase(LAS unsigned char* lds, const Gemm g, const Order& S, const Epi& E) {
    const int tid = opaque_tid(), wid = __builtin_amdgcn_readfirstlane(tid >> 6), lane = tid & 63, wr = wid >> 2, wc = wid & 3, fr = lane & 15, fq = lane >> 4;
    const int K = g.K, nt = K / BK;
    unsigned voffA[2], voffB[2];
#pragma unroll
    for (int i = 0; i < 2; ++i) { int R, C; stage_rc(tid * 16 + i * 8192, R, C); const int Rb = Epi::PERM ? ((R & ~31) + perm32(R & 31)) : R;
        voffA[i] = (unsigned)(R * g.lda + C) * 2u; voffB[i] = (unsigned)(Rb * g.ldb + C) * 2u; }
    const size_t kstep = (size_t)(BK * 2);
    const size_t hstepA = (size_t)HALF * g.lda * 2, hstepB = (size_t)HALF * g.ldb * 2;
    const size_t tstepA = 2 * hstepA, tstepB = 2 * hstepB;
    const unsigned ldsw = (unsigned)wid * 1024u;
    const int aoff = lds_byte(wr * 64 + fr, fq * 8), boff = lds_byte(wc * 32 + fr, fq * 8);
#define PG8_SA(b, h) (((b) * 2 + (h)) * HTB)
#define PG8_SB(b, h) ((4 + (b) * 2 + (h)) * HTB)
#define PG8_STAGE(bufoff, gbase, voff) do { _Pragma("unroll") for (int _i = 0; _i < 2; ++_i) \
        __builtin_amdgcn_global_load_lds((const unsigned*)((const char*)(gbase) + (voff)[_i]), (LAS unsigned*)(lds + (bufoff) + ldsw + _i * 8192), 16, 0, 0); } while (0)
#define PG8_LDA(dst, b, h) do { _Pragma("unroll") for (int m = 0; m < 4; ++m) _Pragma("unroll") for (int k = 0; k < 2; ++k) dst[m][k] = *(const LAS bf16x8*)(lds + PG8_SA(b, h) + aoff + m * 2048 + k * 1024); } while (0)
#define PG8_LDB(dst, b, h) do { _Pragma("unroll") for (int n = 0; n < 2; ++n) _Pragma("unroll") for (int k = 0; k < 2; ++k) dst[n][k] = *(const LAS bf16x8*)(lds + PG8_SB(b, h) + boff + n * 2048 + k * 1024); } while (0)
#define PG8_MMA(ai, bj, At, Bt) do { __builtin_amdgcn_s_setprio(1); _Pragma("unroll") for (int m = 0; m < 4; ++m) _Pragma("unroll") for (int n = 0; n < 2; ++n) _Pragma("unroll") for (int k = 0; k < 2; ++k) \
        acc[ai][bj][m][n] = __builtin_amdgcn_mfma_f32_16x16x32_bf16(Bt[n][k], At[m][k], acc[ai][bj][m][n], 0, 0, 0); __builtin_amdgcn_s_setprio(0); } while (0)
#define PG8_WAIT_V(n) asm volatile("s_waitcnt vmcnt(" #n ")" ::: "memory")
#define PG8_WAIT_L(n) asm volatile("s_waitcnt lgkmcnt(" #n ")" ::: "memory")
#define PG8_BAR __builtin_amdgcn_s_barrier()
#define PG8_SCHED __builtin_amdgcn_sched_barrier(0)
    Unit cur, nxt; int ui = 0;
    if (!S.next(0, cur)) return;
    f32x4 acc[2][2][4][2];
#pragma unroll
    for (int a = 0; a < 2; ++a)
#pragma unroll
        for (int b = 0; b < 2; ++b)
#pragma unroll
            for (int m = 0; m < 4; ++m)
#pragma unroll
                for (int n = 0; n < 2; ++n) acc[a][b][m][n] = (f32x4){0.f, 0.f, 0.f, 0.f};
    bf16x8 At[4][2], B0[2][2], B1[2][2];
    const char* cA = (const char*)g.A + (size_t)cur.pm * tstepA + cur.ao; const char* cB = (const char*)g.Bt + (size_t)cur.pn * tstepB + cur.bo;
    PG8_STAGE(PG8_SB(0, 0), cB, voffB); PG8_STAGE(PG8_SA(0, 0), cA, voffA); PG8_STAGE(PG8_SB(0, 1), cB + hstepB, voffB); PG8_STAGE(PG8_SA(0, 1), cA + hstepA, voffA);
    if (wr == 1) PG8_BAR;
    PG8_WAIT_V(4); PG8_BAR;
    PG8_STAGE(PG8_SB(1, 0), cB + kstep, voffB); PG8_STAGE(PG8_SA(1, 0), cA + kstep, voffA); PG8_STAGE(PG8_SB(1, 1), cB + hstepB + kstep, voffB);
    PG8_WAIT_V(6); PG8_BAR;
    for (;;) {
        const bool has_next = S.next(ui + 1, nxt);
        const char* nA = has_next ? (const char*)g.A + (size_t)nxt.pm * tstepA + nxt.ao : cA; const char* nB = has_next ? (const char*)g.Bt + (size_t)nxt.pn * tstepB + nxt.bo : cB;
        for (int t = 0; t < nt; t += 2) {
            const bool last = (t == nt - 2);
            const char* a1 = cA + (size_t)(t + 1) * kstep;
            const char* a2 = last ? nA : cA + (size_t)(t + 2) * kstep; const char* b2 = last ? nB : cB + (size_t)(t + 2) * kstep;
            const char* a3 = a2 + kstep; const char* b3 = b2 + kstep;
            if constexpr (Epi::HOOK) { if (t == 8 || t == 16) E.mid(acc, cur, t, wr, wc, fr, fq); }
            PG8_LDB(B0, 0, 0); PG8_SCHED; PG8_LDA(At, 0, 0); PG8_STAGE(PG8_SA(1, 1), a1 + hstepA, voffA);
            PG8_WAIT_L(8); PG8_BAR; PG8_WAIT_L(0); PG8_MMA(0, 0, At, B0); PG8_BAR; PG8_SCHED;
            PG8_LDB(B1, 0, 1); PG8_STAGE(PG8_SB(0, 0), b2, voffB);
            PG8_BAR; PG8_WAIT_L(0); PG8_MMA(0, 1, At, B1); PG8_BAR;
            PG8_LDA(At, 0, 1); PG8_STAGE(PG8_SA(0, 0), a2, voffA);
            PG8_BAR; PG8_WAIT_L(0); PG8_MMA(1, 0, At, B0); PG8_BAR; PG8_SCHED;
            PG8_STAGE(PG8_SB(0, 1), b2 + hstepB, voffB);
            PG8_WAIT_V(6); PG8_BAR; PG8_MMA(1, 1, At, B1); PG8_BAR;
            PG8_LDB(B0, 1, 0); PG8_SCHED; PG8_LDA(At, 1, 0); PG8_STAGE(PG8_SA(0, 1), a2 + hstepA, voffA);
            PG8_WAIT_L(8); PG8_BAR; PG8_WAIT_L(0); PG8_MMA(0, 0, At, B0); PG8_BAR; PG8_SCHED;
            PG8_LDB(B1, 1, 1); PG8_STAGE(PG8_SB(1, 0), b3, voffB);
            PG8_BAR; PG8_WAIT_L(0); PG8_MMA(0, 1, At, B1); PG8_BAR;
            PG8_LDA(At, 1, 1); PG8_STAGE(PG8_SA(1, 0), a3, voffA);
            PG8_BAR; PG8_WAIT_L(0); PG8_MMA(1, 0, At, B0); PG8_BAR; PG8_SCHED;
            PG8_STAGE(PG8_SB(1, 1), b3 + hstepB, voffB);
            PG8_WAIT_V(6); PG8_BAR; PG8_MMA(1, 1, At, B1); PG8_BAR;
        }
        E(acc, cur, wr, wc, fr, fq);
        if (!has_next) break;
#pragma unroll
        for (int a = 0; a < 2; ++a)
#pragma unroll
            for (int b = 0; b < 2; ++b)
#pragma unroll
                for (int m = 0; m < 4; ++m)
#pragma unroll
                    for (int n = 0; n < 2; ++n) acc[a][b][m][n] = (f32x4){0.f, 0.f, 0.f, 0.f};
        cur = nxt; cA = nA; cB = nB; ++ui;
    }
    PG8_WAIT_V(0);
    if (wr == 0) PG8_BAR;
    PG8_BAR;
#undef PG8_SA
#undef PG8_SB
#undef PG8_STAGE
#undef PG8_LDA
#undef PG8_LDB
#undef PG8_MMA
#undef PG8_WAIT_V
#undef PG8_WAIT_L
#undef PG8_BAR
#undef PG8_SCHED
}
}
using pg8::Unit;

#define EPI_LOOP_ROWS _Pragma("unroll") for (int ai = 0; ai < 2; ++ai) _Pragma("unroll") for (int m = 0; m < 4; ++m)
__device__ __forceinline__ uint4 pack8(f32x4 a, f32x4 b) { uint4 o; o.x = pk2(a[0], a[1]); o.y = pk2(a[2], a[3]); o.z = pk2(b[0], b[1]); o.w = pk2(b[2], b[3]); return o; }

struct EpiZ {
    static constexpr bool PERM = true, HOOK = false;
    bf16_t* Z;
    __device__ __forceinline__ void operator()(const f32x4 (&acc)[2][2][4][2], const Unit& u, int wr, int wc, int fr_, int fq_) const {
        int fr = fr_, fq = fq_; asm volatile("" : "+v"(fr), "+v"(fq));
        const int mode = (u.pn >= 14 && u.pn < 26) ? 2 : ((u.pn >= 10 && u.pn < 14) ? 1 : 0);
        const int row0 = u.pm * 256 + wr * 64 + fr, col0 = u.pn * 256 + wc * 32 + 8 * fq;
        EPI_LOOP_ROWS { bf16_t* rp = Z + (size_t)(row0 + ai * 128 + m * 16) * NZ + col0;
#pragma unroll
            for (int bj = 0; bj < 2; ++bj) { f32x4 v0 = acc[ai][bj][m][0], v1 = acc[ai][bj][m][1];
                if (mode == 1) { _Pragma("unroll") for (int j = 0; j < 4; ++j) { v0[j] = gelu_exact(v0[j]); v1[j] = gelu_exact(v1[j]); } }
                else if (mode == 2) { _Pragma("unroll") for (int j = 0; j < 4; ++j) { v0[j] = sigmoidf_(v0[j]); v1[j] = sigmoidf_(v1[j]); } }
                *(uint4*)(rp + bj * 128) = pack8(v0, v1); } }
    }
};
struct EpiQ {
    static constexpr bool PERM = false, HOOK = false;
    bf16_t* Q; const float* rope;
    __device__ __forceinline__ void operator()(const f32x4 (&acc)[2][2][4][2], const Unit& u, int wr, int wc, int fr_, int fq_) const {
        int fr = fr_, fq = fq_; asm volatile("" : "+v"(fr), "+v"(fq));
        const int row0 = u.pm * 256 + wr * 64 + fr;
        const bool rp0 = (((u.pn * 256 + wc * 32) >> 5) % 3) == 2, rp1 = (((u.pn * 256 + 128 + wc * 32) >> 5) % 3) == 2, anyr = rp0 || rp1;
        f32x4 c0n = {1.f, 0.f, 1.f, 0.f}, c1n = c0n;
#define EQ_PIDX(row_) ((row_) < TP ? ((row_) & (SEQ - 1)) : (SEQ + (((row_) - TP) & (DSEQ - 1))))
        if (anyr) { const float* rp = rope + ((size_t)EQ_PIDX(row0) * 16 + 4 * fq) * 2; c0n = *(const f32x4*)rp; c1n = *(const f32x4*)(rp + 4); }
#pragma unroll
        for (int s8 = 0; s8 < 8; ++s8) { const int ai = s8 >> 2, m = s8 & 3; const int row = row0 + ai * 128 + m * 16; const f32x4 c0 = c0n, c1 = c1n;
            if (anyr && s8 + 1 < 8) { const int rown = row0 + ((s8 + 1) >> 2) * 128 + ((s8 + 1) & 3) * 16; const float* rp = rope + ((size_t)EQ_PIDX(rown) * 16 + 4 * fq) * 2; c0n = *(const f32x4*)rp; c1n = *(const f32x4*)(rp + 4); }
            const float cs[4] = {c0[0], c0[2], c1[0], c1[2]}, sn[4] = {c0[1], c0[3], c1[1], c1[3]};
#pragma unroll
            for (int bj = 0; bj < 2; ++bj) { const int cb = u.pn * 256 + bj * 128 + wc * 32; f32x4 v0 = acc[ai][bj][m][0] * QSCALE, v1 = acc[ai][bj][m][1] * QSCALE;
                if (bj ? rp1 : rp0) { _Pragma("unroll") for (int j = 0; j < 4; ++j) { const float a = v0[j], b = v1[j]; v0[j] = a * cs[j] - b * sn[j]; v1[j] = b * cs[j] + a * sn[j]; } }
                bf16_t* dp = Q + (size_t)row * 768 + cb + 4 * fq;
                *(uint2*)dp = make_uint2(pk2(v0[0], v0[1]), pk2(v0[2], v0[3])); *(uint2*)(dp + 16) = make_uint2(pk2(v1[0], v1[1]), pk2(v1[2], v1[3])); }
            __builtin_amdgcn_sched_barrier(0); }
#undef EQ_PIDX
    }
};
struct EpiKN {
    static constexpr bool PERM = true, HOOK = false;
    bf16_t* KN; bf16_t* KNS; int mode;
    __device__ __forceinline__ void operator()(const f32x4 (&acc)[2][2][4][2], const Unit& u, int wr, int wc, int fr_, int fq_) const {
        int fr = fr_, fq = fq_; asm volatile("" : "+v"(fr), "+v"(fq));
        const int row0 = u.pm * 256 + wr * 64 + fr, col0 = u.pn * 256 + wc * 32 + 8 * fq;
        EPI_LOOP_ROWS { const int row = row0 + ai * 128 + m * 16; bf16_t* rp;
            if (mode == 1) rp = KNS + ((size_t)(row >> 12) * KSS + (row & 4095)) * 512;
            else if (row < TP) rp = KN + (size_t)row * 512;
            else { const int s = row - TP; rp = KNS + ((size_t)(s >> 5) * KSS + PAST + (s & 31)) * 512; }
#pragma unroll
            for (int bj = 0; bj < 2; ++bj) *(uint4*)(rp + col0 + bj * 128) = pack8(acc[ai][bj][m][0], acc[ai][bj][m][1]); }
    }
};
struct EpiVT {
    static constexpr bool PERM = true, HOOK = false;
    bf16_t* VT; bf16_t* VTS; int mode;
    __device__ __forceinline__ void operator()(const f32x4 (&acc)[2][2][4][2], const Unit& u, int wr, int wc, int fr_, int fq_) const {
        int fr = fr_, fq = fq_; asm volatile("" : "+v"(fr), "+v"(fq));
        const int row0 = u.pm * 256 + wr * 64 + fr, col0 = u.pn * 256 + wc * 32 + 8 * fq;
        EPI_LOOP_ROWS { const int row = row0 + ai * 128 + m * 16;
#pragma unroll
            for (int bj = 0; bj < 2; ++bj) { const int col = col0 + bj * 128; bf16_t* dp;
                if (mode == 1) dp = VTS + ((size_t)(col >> 12) * 512 + row) * KSS + (col & 4095);
                else if (col < TP) dp = VT + ((size_t)(col >> 11) * 512 + row) * SEQ + (col & (SEQ - 1));
                else { const int s = col - TP; dp = VTS + ((size_t)(s >> 5) * 512 + row) * KSS + PAST + (s & 31); }
                *(uint4*)dp = pack8(acc[ai][bj][m][0], acc[ai][bj][m][1]); } }
    }
};
struct EpiMerge {
    static constexpr bool PERM = true, HOOK = true;
    bf16_t* Mo; const bf16_t* Z;
    __device__ __forceinline__ void mid(f32x4 (&acc)[2][2][4][2], const Unit& u, int t, int wr, int wc, int fr_, int fq_) const {
        int fr = fr_, fq = fq_; asm volatile("" : "+v"(fr), "+v"(fq));
        const int row0 = u.pm * 256 + wr * 64 + fr, col0 = u.pn * 256 + wc * 32 + 8 * fq; const int gp = (t == 8) ? ZGA : ZGB;
        const bf16_t* base = Z + (size_t)row0 * NZ + col0 + gp;
#define MG_OFF(s_) ((size_t)((((s_) >> 3) & 1) * 128 + (((s_) >> 1) & 3) * 16) * NZ + ((s_) & 1) * 128)
        uint4 pn = *(const uint4*)(base + MG_OFF(0)), qn = *(const uint4*)(base + MG_OFF(0) + 1024);
#pragma unroll
        for (int st = 0; st < 16; ++st) { const int ai = st >> 3, m = (st >> 1) & 3, bj = st & 1; const uint4 p = pn, q = qn;
            if (st + 1 < 16) { pn = *(const uint4*)(base + MG_OFF(st + 1)); qn = *(const uint4*)(base + MG_OFF(st + 1) + 1024); }
            const unsigned pu[4] = {p.x, p.y, p.z, p.w}, qu[4] = {q.x, q.y, q.z, q.w};
#pragma unroll
            for (int n = 0; n < 2; ++n)
#pragma unroll
                for (int j = 0; j < 4; ++j) { const unsigned a_ = pu[n * 2 + (j >> 1)], b_ = qu[n * 2 + (j >> 1)];
                    const float sp = (j & 1) ? hi16(a_) : lo16(a_), sq = (j & 1) ? hi16(b_) : lo16(b_);
                    acc[ai][bj][m][n][j] *= sp * __builtin_amdgcn_rcpf(fmaxf(sq, 1e-30f)); }
            __builtin_amdgcn_sched_barrier(0); }
#undef MG_OFF
    }
    __device__ __forceinline__ void operator()(const f32x4 (&acc)[2][2][4][2], const Unit& u, int wr, int wc, int fr_, int fq_) const {
        int fr = fr_, fq = fq_; asm volatile("" : "+v"(fr), "+v"(fq));
        const int row0 = u.pm * 256 + wr * 64 + fr, col0 = u.pn * 256 + wc * 32 + 8 * fq;
        const bf16_t* base = Z + (size_t)row0 * NZ + ZGC + col0;
#define MG_OFF(s_) ((size_t)((((s_) >> 3) & 1) * 128 + (((s_) >> 1) & 3) * 16) * NZ + ((s_) & 1) * 128)
        uint4 pn = *(const uint4*)(base + MG_OFF(0));
#pragma unroll
        for (int st = 0; st < 16; ++st) { const int ai = st >> 3, m = (st >> 1) & 3, bj = st & 1; const uint4 p = pn; const int row = row0 + ai * 128 + m * 16;
            if (st + 1 < 16) pn = *(const uint4*)(base + MG_OFF(st + 1));
            const unsigned pu[4] = {p.x, p.y, p.z, p.w};
            f32x4 v0 = acc[ai][bj][m][0], v1 = acc[ai][bj][m][1];
            v0[0] *= lo16(pu[0]); v0[1] *= hi16(pu[0]); v0[2] *= lo16(pu[1]); v0[3] *= hi16(pu[1]);
            v1[0] *= lo16(pu[2]); v1[1] *= hi16(pu[2]); v1[2] *= lo16(pu[3]); v1[3] *= hi16(pu[3]);
            *(uint4*)(Mo + (size_t)row * 1024 + col0 + bj * 128) = pack8(v0, v1); }
#undef MG_OFF
    }
};
struct EpiRes {
    static constexpr bool PERM = false, HOOK = false;
    float* X; const float* ST; const float* G; const float* B;
    __device__ __forceinline__ void operator()(const f32x4 (&acc)[2][2][4][2], const Unit& u, int wr, int wc, int fr_, int fq_) const {
        int fr = fr_, fq = fq_; asm volatile("" : "+v"(fr), "+v"(fq));
        const int row0 = u.pm * 256 + wr * 64 + fr, col0 = u.pn * 256 + wc * 32 + 4 * fq;
        f32x4 gv[2][2], bv[2][2];
        if (ST) {
#pragma unroll
            for (int bj = 0; bj < 2; ++bj)
#pragma unroll
                for (int n = 0; n < 2; ++n) { gv[bj][n] = *(const f32x4*)(G + col0 + bj * 128 + n * 16); bv[bj][n] = *(const f32x4*)(B + col0 + bj * 128 + n * 16); } }
        f32x4 xn[2][2]; f32x2 stn = {0.f, 1.f};
        {   const float* rp0 = X + (size_t)row0 * 1024 + col0;
#pragma unroll
            for (int bj = 0; bj < 2; ++bj)
#pragma unroll
                for (int n = 0; n < 2; ++n) xn[bj][n] = *(const f32x4*)(rp0 + bj * 128 + n * 16);
            if (ST) stn = *(const f32x2*)(ST + (size_t)row0 * 2); }
#pragma unroll
        for (int s = 0; s < 8; ++s) { const int ai = s >> 2, m = s & 3; const int row = row0 + ai * 128 + m * 16; float* rp = X + (size_t)row * 1024 + col0;
            f32x4 xc[2][2]; const f32x2 st = stn;
#pragma unroll
            for (int bj = 0; bj < 2; ++bj)
#pragma unroll
                for (int n = 0; n < 2; ++n) xc[bj][n] = xn[bj][n];
            if (s + 1 < 8) { const int rown = row0 + ((s + 1) >> 2) * 128 + ((s + 1) & 3) * 16; const float* rpn = X + (size_t)rown * 1024 + col0;
#pragma unroll
                for (int bj = 0; bj < 2; ++bj)
#pragma unroll
                    for (int n = 0; n < 2; ++n) xn[bj][n] = *(const f32x4*)(rpn + bj * 128 + n * 16);
                if (ST) stn = *(const f32x2*)(ST + (size_t)rown * 2); }
#pragma unroll
            for (int bj = 0; bj < 2; ++bj)
#pragma unroll
                for (int n = 0; n < 2; ++n) { f32x4 x = xc[bj][n]; if (ST) x = (x - st[0]) * st[1] * gv[bj][n] + bv[bj][n]; *(f32x4*)(rp + bj * 128 + n * 16) = x * ALPHA + acc[ai][bj][m][n]; }
            __builtin_amdgcn_sched_barrier(0); }
    }
};
struct EpiUp {
    static constexpr bool PERM = true, HOOK = false;
    bf16_t* H;
    __device__ __forceinline__ void operator()(const f32x4 (&acc)[2][2][4][2], const Unit& u, int wr, int wc, int fr_, int fq_) const {
        int fr = fr_, fq = fq_; asm volatile("" : "+v"(fr), "+v"(fq));
        const int row0 = u.pm * 256 + wr * 64 + fr, col0 = u.pn * 128 + wc * 32 + 8 * fq;
        EPI_LOOP_ROWS { f32x4 v0, v1;
#pragma unroll
            for (int j = 0; j < 4; ++j) { const float g0 = acc[ai][0][m][0][j], g1 = acc[ai][0][m][1][j];
                v0[j] = g0 * sigmoidf_(g0) * acc[ai][1][m][0][j]; v1[j] = g1 * sigmoidf_(g1) * acc[ai][1][m][1][j]; }
            *(uint4*)(H + (size_t)(row0 + ai * 128 + m * 16) * DFF + col0) = pack8(v0, v1); }
    }
};


struct EpiKV4 {
    static constexpr bool PERM = true, HOOK = false;
    EpiKN kn0, kn1; EpiVT vt0, vt1;
    __device__ __forceinline__ void operator()(const f32x4 (&acc)[2][2][4][2], const Unit& u, int wr, int wc, int fr, int fq) const {
        if (u.g == 0) kn0(acc, u, wr, wc, fr, fq); else if (u.g == 1) vt0(acc, u, wr, wc, fr, fq); else if (u.g == 2) kn1(acc, u, wr, wc, fr, fq); else vt1(acc, u, wr, wc, fr, fq);
    }
};
struct KV4Order {
    int G, c; long oW, oWv, oC, oX;
    __device__ bool next(int i, Unit& u) const {
        int L;
        if (G != 256) { L = i * G + c; if (L >= 772) return false; }
        else if (i < 3) L = i * 256 + c;
        else { const int e = c - 195; if (i > 3 || e < 0 || e >= 4) return false; L = 768 + e; }
        int g, idx;
        if (L < 130) { g = 0; idx = L; } else if (L < 260) { g = 1; idx = L - 130; } else if (L < 516) { g = 2; idx = L - 260; } else { g = 3; idx = L - 516; }
        u.g = g;
        if (g == 0 || g == 2) { u.pm = idx >> 1; u.pn = idx & 1; } else { const int nn = (g == 1) ? 65 : 128; u.pm = idx / nn; u.pn = idx - u.pm * nn; }
        u.ao = oC + (long)(g & 1) * (oWv - oC) + (long)(g == 2) * (oX - oC); u.bo = oW + (long)(g == 1) * (oC - oW) + (long)(g == 3) * (oX - oW); return true;
    }
};

template <class Epi>
__device__ __forceinline__ void run_gemm(unsigned char* smem, const bf16_t* A, int lda, const bf16_t* Bt, int ldb, int M, int N, int K, int rot, const Epi& E) {
    int Kop = K; asm volatile("" : "+s"(Kop));
    pg8::Gemm g; g.A = A; g.Bt = Bt; g.M = M; g.N = N; g.K = Kop; g.lda = lda; g.ldb = ldb;
    pg8::StaticOrder S; S.init(M, N, (int)gridDim.x, (int)((blockIdx.x + gridDim.x - (rot % gridDim.x)) % gridDim.x));
    pg8::gemm_phase<Epi, pg8::StaticOrder>((LAS unsigned char*)smem, g, S, E);
    __syncthreads();
}


template <int NSEG, int MODE>
__device__ __forceinline__ void skinny_gemm(unsigned char* smem, const Params& p, const bf16_t* A, int lda, const bf16_t* Bt, int ldb, int Kseg, const float* ST = nullptr, const float* Gp = nullptr, const float* Bp = nullptr) {
    const int tid = opaque_tid(), lane = tid & 63, w = tid >> 6, fr = lane & 15, fq = lane >> 4;
    float* part = (float*)smem;
    for (int tile = blockIdx.x; tile < 256; tile += gridDim.x) {
        const int rt = tile >> 5, ct = tile & 31;
        const bf16_t* ap = A + (size_t)(TP + 32 * rt + fr) * lda + fq * 8;
        const bf16_t* bp = Bt + (size_t)(32 * ct + fr) * ldb + fq * 8;
#pragma unroll
        for (int seg = 0; seg < NSEG; ++seg) {
            f32x4 acc[2][2];
#pragma unroll
            for (int i = 0; i < 2; ++i) { acc[i][0] = (f32x4){0.f, 0.f, 0.f, 0.f}; acc[i][1] = (f32x4){0.f, 0.f, 0.f, 0.f}; }
#pragma unroll 4
            for (int st = w; st < (Kseg >> 5); st += 8) { const int k0 = seg * Kseg + st * 32;
                const bf16x8 a0 = *(const bf16x8*)(ap + k0), a1 = *(const bf16x8*)(ap + (size_t)16 * lda + k0);
                const bf16x8 b0 = *(const bf16x8*)(bp + k0), b1 = *(const bf16x8*)(bp + (size_t)16 * ldb + k0);
                acc[0][0] = mfma16(b0, a0, acc[0][0]); acc[0][1] = mfma16(b1, a0, acc[0][1]); acc[1][0] = mfma16(b0, a1, acc[1][0]); acc[1][1] = mfma16(b1, a1, acc[1][1]); }
#pragma unroll
            for (int mt = 0; mt < 2; ++mt)
#pragma unroll
                for (int nt = 0; nt < 2; ++nt) *(f32x4*)(part + ((size_t)((seg * 8 + w) * 32 + mt * 16 + fr)) * 32 + nt * 16 + 4 * fq) = acc[mt][nt];
        }
        __syncthreads();
        {   const int row = tid >> 4, c0 = (tid & 15) * 2; const int rg = TP + 32 * rt + row, cg_ = 32 * ct + c0;
            float v[NSEG][2];
#pragma unroll
            for (int seg = 0; seg < NSEG; ++seg) { v[seg][0] = 0.f; v[seg][1] = 0.f;
#pragma unroll
                for (int ww = 0; ww < 8; ++ww) { const f32x2 t = *(const f32x2*)(part + ((size_t)((seg * 8 + ww) * 32 + row)) * 32 + c0); v[seg][0] += t[0]; v[seg][1] += t[1]; } }
            if (MODE == 0) { f32x2* xp = (f32x2*)(p.out + O_YP + (size_t)rg * 1024 + cg_); f32x2 x = *xp;
                if (ST) { const f32x2 st = *(const f32x2*)(ST + (size_t)rg * 2); const f32x2 g2 = *(const f32x2*)(Gp + cg_), b2 = *(const f32x2*)(Bp + cg_); x = (x - st[0]) * st[1] * g2 + b2; }
                x[0] = x[0] * ALPHA + v[0][0]; x[1] = x[1] * ALPHA + v[0][1]; *xp = x; }
            else { const bf16_t* Z = (const bf16_t*)(p.ws + WS_Z); float o0 = 0.f, o1 = 0.f;
#pragma unroll
                for (int seg = 0; seg < NSEG; ++seg) { const unsigned gte = *(const unsigned*)(Z + (size_t)rg * NZ + ZGA + 1024 * seg + cg_); o0 += lo16(gte) * v[seg][0]; o1 += hi16(gte) * v[seg][1]; }
                *(unsigned*)((bf16_t*)(p.ws + WS_XB) + (size_t)rg * 1024 + cg_) = pk2(o0, o1); }
        }
        __syncthreads();
    }
}

__device__ __forceinline__ int srccol(int map, int n) {
    if (map == 0) return n;
    if (map == 1) { if (n < 512) return n; if (n < ZKR) return n + 32; if (n < ZKR + 32) return n - ZKR + 512; return -1; }
    const int u = n >> 8, bj = (n >> 7) & 1, j = n & 127; return bj * DFF + u * 128 + j;
}
__device__ __forceinline__ void conv_w(unsigned char* smem, const float* src, int ldsrc, int K, bf16_t* dst, int ldd, int koff, int Ndst, int map, int& base) {
    const int tid = opaque_tid(), G = gridDim.x, nk = K >> 6, ntl = (Ndst >> 6) * nk;
    bf16_t* T = (bf16_t*)smem;
    const int first = ((int)blockIdx.x - (base % G) + G) % G;
    const int c4 = (tid & 15) * 4, r = tid >> 4;
    f32x4 v0 = {0.f, 0.f, 0.f, 0.f}, v1 = {0.f, 0.f, 0.f, 0.f};
#define CONV_LOAD(tile_) do { const int tn_ = (tile_) / nk, tk_ = (tile_) - tn_ * nk; const int sc_ = srccol(map, tn_ * 64 + c4); v0 = (f32x4){0.f, 0.f, 0.f, 0.f}; v1 = v0; \
        if (sc_ >= 0) { v0 = __builtin_nontemporal_load((const f32x4*)(src + (size_t)(tk_ * 64 + r) * ldsrc + sc_)); v1 = __builtin_nontemporal_load((const f32x4*)(src + (size_t)(tk_ * 64 + r + 32) * ldsrc + sc_)); } } while (0)
    if (first < ntl) CONV_LOAD(first);
    for (int tile = first; tile < ntl; tile += G) {
        const int tn = tile / nk, tk = tile - tn * nk, n0 = tn * 64, k0 = tk * 64;
        const f32x4 a0 = v0, a1 = v1;
        if (tile + G < ntl) CONV_LOAD(tile + G);
        T[(c4 + 0) * 72 + r] = f2bf(a0[0]); T[(c4 + 1) * 72 + r] = f2bf(a0[1]); T[(c4 + 2) * 72 + r] = f2bf(a0[2]); T[(c4 + 3) * 72 + r] = f2bf(a0[3]);
        T[(c4 + 0) * 72 + r + 32] = f2bf(a1[0]); T[(c4 + 1) * 72 + r + 32] = f2bf(a1[1]); T[(c4 + 2) * 72 + r + 32] = f2bf(a1[2]); T[(c4 + 3) * 72 + r + 32] = f2bf(a1[3]);
        __syncthreads();
        const int row = tid >> 3, seg = tid & 7;
        if (map == 1) *(uint4*)(dst + (size_t)(n0 + row) * ldd + koff + k0 + seg * 8) = *(const uint4*)(T + row * 72 + seg * 8);
        else stnt4(dst + (size_t)(n0 + row) * ldd + koff + k0 + seg * 8, *(const uint4*)(T + row * 72 + seg * 8));
        __syncthreads();
    }
#undef CONV_LOAD
    base += ntl;
}
__device__ __forceinline__ void conv_layer(unsigned char* smem, const Params& p, int l) {
    bf16_t* W = (bf16_t*)(p.ws + WS_WT); int base = 0;
    conv_w(smem, p.in[7] + (size_t)l * 1024 * 6688, 6688, 1024, W + W_IN, 1024, 0, NZ, 1, base);
    conv_w(smem, p.in[9] + (size_t)l * 256 * 768, 768, 256, W + W_UQ, 256, 0, 768, 0, base);
    conv_w(smem, p.in[10] + (size_t)l * 256 * 512, 512, 256, W + W_UKV, 256, 0, 512, 0, base);
    conv_w(smem, p.in[12] + (size_t)l * 256 * 512, 512, 256, W + W_UKV + 512 * 256, 256, 0, 512, 0, base);
    conv_w(smem, p.in[19] + (size_t)l * 512 * 1024, 1024, 512, W + W_CAT, 1536, 0, 1024, 0, base);
    conv_w(smem, p.in[20] + (size_t)l * 512 * 1024, 1024, 512, W + W_CAT, 1536, 512, 1024, 0, base);
    conv_w(smem, p.in[21] + (size_t)l * 512 * 1024, 1024, 512, W + W_CAT, 1536, 1024, 1024, 0, base);
    conv_w(smem, p.in[22] + (size_t)l * 1024 * 1024, 1024, 1024, W + W_O, 1024, 0, 1024, 0, base);
    conv_w(smem, p.in[25] + (size_t)l * 1024 * 5632, 5632, 1024, W + W_UP, 1024, 0, 5632, 2, base);
    conv_w(smem, p.in[26] + (size_t)l * DFF * 1024, 1024, DFF, W + W_DN, DFF, 0, 1024, 0, base);
}

__device__ __forceinline__ void ln_rows(const float* srcP, const float* srcS, float* X, bf16_t* XB, const float* g, const float* b, float* ST, bool writeX, bool nt_in = false) {
    const int tid_ = opaque_tid(); const int lane = tid_ & 63, gw = blockIdx.x * 8 + (tid_ >> 6), nw = gridDim.x * 8;
    f32x4 gv[4], bv[4];
#pragma unroll
    for (int i = 0; i < 4; ++i) { gv[i] = *(const f32x4*)(g + i * 256 + lane * 4); bv[i] = *(const f32x4*)(b + i * 256 + lane * 4); }
    f32x4 vn[2][4];
#define LN_LOAD(r0_) do { const int ra_ = (r0_), rb_ = ((r0_) + nw < TT) ? (r0_) + nw : (r0_); \
        const float* pa_ = (ra_ < TP) ? srcP + (size_t)ra_ * 1024 : srcS + (size_t)(ra_ - TP) * 1024; const float* pb_ = (rb_ < TP) ? srcP + (size_t)rb_ * 1024 : srcS + (size_t)(rb_ - TP) * 1024; \
        if (nt_in) { _Pragma("unroll") for (int i = 0; i < 4; ++i) { vn[0][i] = __builtin_nontemporal_load((const f32x4*)(pa_ + i * 256 + lane * 4)); vn[1][i] = __builtin_nontemporal_load((const f32x4*)(pb_ + i * 256 + lane * 4)); } } \
        else { _Pragma("unroll") for (int i = 0; i < 4; ++i) { vn[0][i] = *(const f32x4*)(pa_ + i * 256 + lane * 4); vn[1][i] = *(const f32x4*)(pb_ + i * 256 + lane * 4); } } } while (0)
    if (gw < TT) LN_LOAD(gw);
    for (int row0 = gw; row0 < TT; row0 += 2 * nw) {
        const int row1 = row0 + nw; const bool has1 = row1 < TT;
        f32x4 v[2][4]; float s0 = 0.f, s1 = 0.f;
#pragma unroll
        for (int i = 0; i < 4; ++i) { v[0][i] = vn[0][i]; v[1][i] = vn[1][i]; }
        if (row0 + 2 * nw < TT) LN_LOAD(row0 + 2 * nw);
#pragma unroll
        for (int i = 0; i < 4; ++i) { s0 += v[0][i][0] + v[0][i][1] + v[0][i][2] + v[0][i][3]; s1 += v[1][i][0] + v[1][i][1] + v[1][i][2] + v[1][i][3]; }
        s0 = wave_sum(s0); s1 = wave_sum(s1);
        const float mu0 = s0 * (1.0f / 1024.0f), mu1 = s1 * (1.0f / 1024.0f); float q0 = 0.f, q1 = 0.f;
#pragma unroll
        for (int i = 0; i < 4; ++i) { v[0][i] = v[0][i] - mu0; v[1][i] = v[1][i] - mu1;
            q0 += v[0][i][0] * v[0][i][0] + v[0][i][1] * v[0][i][1] + v[0][i][2] * v[0][i][2] + v[0][i][3] * v[0][i][3];
            q1 += v[1][i][0] * v[1][i][0] + v[1][i][1] * v[1][i][1] + v[1][i][2] * v[1][i][2] + v[1][i][3] * v[1][i][3]; }
        q0 = wave_sum(q0); q1 = wave_sum(q1);
        const float rs0 = rsqrtf(q0 * (1.0f / 1024.0f) + EPS), rs1 = rsqrtf(q1 * (1.0f / 1024.0f) + EPS);
        if (ST && lane == 0) { *(f32x2*)(ST + (size_t)row0 * 2) = (f32x2){mu0, rs0}; if (has1) *(f32x2*)(ST + (size_t)row1 * 2) = (f32x2){mu1, rs1}; }
#pragma unroll
        for (int i = 0; i < 4; ++i) { const f32x4 o = v[0][i] * rs0 * gv[i] + bv[i];
            if (writeX) *(f32x4*)(X + (size_t)row0 * 1024 + i * 256 + lane * 4) = o;
            *(uint2*)(XB + (size_t)row0 * 1024 + i * 256 + lane * 4) = make_uint2(pk2(o[0], o[1]), pk2(o[2], o[3])); }
        if (has1) {
#pragma unroll
            for (int i = 0; i < 4; ++i) { const f32x4 o = v[1][i] * rs1 * gv[i] + bv[i];
                if (writeX) *(f32x4*)(X + (size_t)row1 * 1024 + i * 256 + lane * 4) = o;
                *(uint2*)(XB + (size_t)row1 * 1024 + i * 256 + lane * 4) = make_uint2(pk2(o[0], o[1]), pk2(o[2], o[3])); } }
    }
}

__device__ __forceinline__ void rowops(const Params& p, int l) {
    const int tid_ = opaque_tid(); const int lane = tid_ & 63, gw = blockIdx.x * 8 + (tid_ >> 6), nw = gridDim.x * 8;
    bf16_t* Z = (bf16_t*)(p.ws + WS_Z); const float* rope = (const float*)(p.ws + WS_ROPE);
    bf16_t* KRB = (bf16_t*)(p.ws + WS_KRB); bf16_t* KRS = (bf16_t*)(p.ws + WS_KRS);
    const f32x4 gq = *(const f32x4*)(p.in[8] + l * 256 + lane * 4), gk = *(const f32x4*)(p.in[11] + l * 256 + lane * 4);
    const f32x4 lg0 = *(const f32x4*)(p.in[15] + l * 512 + lane * 8), lg1 = *(const f32x4*)(p.in[15] + l * 512 + lane * 8 + 4);
    const f32x4 lb0 = *(const f32x4*)(p.in[16] + l * 512 + lane * 8), lb1 = *(const f32x4*)(p.in[16] + l * 512 + lane * 8 + 4);
    uint2 uqn[2], ukn[2]; uint4 uvn[2]; bf16_t x1n[2], x2n[2];
#define RO_LOAD(t0_) do { const int ta_[2] = {(t0_), ((t0_) + nw < TT) ? (t0_) + nw : (t0_)}; \
        _Pragma("unroll") for (int e = 0; e < 2; ++e) { const bf16_t* zr = Z + (size_t)ta_[e] * NZ; \
            uqn[e] = *(const uint2*)(zr + ZCQ + lane * 4); ukn[e] = *(const uint2*)(zr + ZCKV + lane * 4); uvn[e] = *(const uint4*)(zr + ZCV + lane * 8); \
            x1n[e] = zr[ZKR + (lane & 15)]; x2n[e] = zr[ZKR + 16 + (lane & 15)]; } } while (0)
    if (gw < TT) RO_LOAD(gw);
    for (int tok0 = gw; tok0 < TT; tok0 += 2 * nw) {
        const bool has1 = tok0 + nw < TT; const int toks[2] = {tok0, has1 ? tok0 + nw : tok0};
        uint2 uq[2], uk[2]; uint4 uv[2]; float x1[2], x2[2];
#pragma unroll
        for (int e = 0; e < 2; ++e) { uq[e] = uqn[e]; uk[e] = ukn[e]; uv[e] = uvn[e]; x1[e] = bf2f(x1n[e]); x2[e] = bf2f(x2n[e]); }
        if (tok0 + 2 * nw < TT) RO_LOAD(tok0 + 2 * nw);
        f32x4 vq[2], vk[2], va[2], vc[2]; float sq[2], sk[2], sv[2];
#pragma unroll
        for (int e = 0; e < 2; ++e) { vq[e] = (f32x4){lo16(uq[e].x), hi16(uq[e].x), lo16(uq[e].y), hi16(uq[e].y)}; vk[e] = (f32x4){lo16(uk[e].x), hi16(uk[e].x), lo16(uk[e].y), hi16(uk[e].y)};
            va[e] = (f32x4){lo16(uv[e].x), hi16(uv[e].x), lo16(uv[e].y), hi16(uv[e].y)}; vc[e] = (f32x4){lo16(uv[e].z), hi16(uv[e].z), lo16(uv[e].w), hi16(uv[e].w)};
            sq[e] = vq[e][0] * vq[e][0] + vq[e][1] * vq[e][1] + vq[e][2] * vq[e][2] + vq[e][3] * vq[e][3];
            sk[e] = vk[e][0] * vk[e][0] + vk[e][1] * vk[e][1] + vk[e][2] * vk[e][2] + vk[e][3] * vk[e][3];
            sv[e] = va[e][0] + va[e][1] + va[e][2] + va[e][3] + vc[e][0] + vc[e][1] + vc[e][2] + vc[e][3]; }
#pragma unroll
        for (int e = 0; e < 2; ++e) { sq[e] = wave_sum(sq[e]); sk[e] = wave_sum(sk[e]); sv[e] = wave_sum(sv[e]); }
        float s2[2];
#pragma unroll
        for (int e = 0; e < 2; ++e) { const float mu = sv[e] * (1.0f / 512.0f); va[e] = va[e] - mu; vc[e] = vc[e] - mu;
            s2[e] = va[e][0] * va[e][0] + va[e][1] * va[e][1] + va[e][2] * va[e][2] + va[e][3] * va[e][3] + vc[e][0] * vc[e][0] + vc[e][1] * vc[e][1] + vc[e][2] * vc[e][2] + vc[e][3] * vc[e][3]; }
#pragma unroll
        for (int e = 0; e < 2; ++e) s2[e] = wave_sum(s2[e]);
#pragma unroll
        for (int e = 0; e < 2; ++e) {
            if (e == 1 && !has1) break;
            const int tok = toks[e]; bf16_t* zr = Z + (size_t)tok * NZ; const bool smp = tok >= TP; const int s = tok - TP;
            {   const f32x4 v = vq[e] * rsqrtf(sq[e] * (1.0f / 256.0f) + EPS) * gq; *(uint2*)(zr + ZCQ + lane * 4) = make_uint2(pk2(v[0], v[1]), pk2(v[2], v[3])); }
            {   const f32x4 v = vk[e] * rsqrtf(sk[e] * (1.0f / 256.0f) + EPS) * gk; *(uint2*)((bf16_t*)(p.ws + WS_CKVN) + (size_t)tok * 256 + lane * 4) = make_uint2(pk2(v[0], v[1]), pk2(v[2], v[3]));
                float* op = smp ? p.out + O_CKVS + ((size_t)l * TS + s) * 256 : p.out + O_CKVP + ((size_t)l * TP + tok) * 256;
                __builtin_nontemporal_store(v, (f32x4*)(op + lane * 4)); }
            if (lane < 16) {
                const int pidx = smp ? SEQ + (s & 31) : (tok & (SEQ - 1));
                const f32x2 cs = *(const f32x2*)(rope + ((size_t)pidx * 16 + lane) * 2);
                const float o1 = x1[e] * cs[0] - x2[e] * cs[1], o2 = x2[e] * cs[0] + x1[e] * cs[1];
                float* op = smp ? p.out + O_KRS + ((size_t)l * TS + s) * 32 : p.out + O_KRP + ((size_t)l * TP + tok) * 32;
                op[lane] = o1; op[16 + lane] = o2;
                bf16_t* kb = smp ? KRS + ((size_t)(s >> 5) * KSS + PAST + (s & 31)) * 32 : KRB + (size_t)tok * 32;
                kb[lane] = f2bf(o1); kb[16 + lane] = f2bf(o2); }
            {   const float rs = rsqrtf(s2[e] * (1.0f / 512.0f) + EPS); const f32x4 a = va[e] * rs * lg0 + lb0, c = vc[e] * rs * lg1 + lb1;
                *(uint4*)(zr + ZCV + lane * 8) = pack8(a, c);
                if (smp) { float* op = p.out + O_VS + ((size_t)l * TS + s) * 512 + lane * 8; *(f32x4*)op = a; *(f32x4*)(op + 4) = c; } }
        }
    }
}
__device__ __forceinline__ void cache_conv(const Params& p, int l) {
    const size_t gt = (size_t)blockIdx.x * 512 + opaque_tid(), nth = (size_t)gridDim.x * 512;
    const float* src = p.in[2] + (size_t)l * 8 * PAST * 256; bf16_t* dst = (bf16_t*)(p.ws + WS_XB);
    constexpr size_t NC = (size_t)8 * PAST * 256 / 8;
    for (size_t i = gt; i < NC; i += 4 * nth) { f32x4 a[4], b[4];
#pragma unroll
        for (int e = 0; e < 4; ++e) { const size_t j = i + e * nth; if (j < NC) { a[e] = __builtin_nontemporal_load((const f32x4*)(src + j * 8)); b[e] = __builtin_nontemporal_load((const f32x4*)(src + j * 8 + 4)); } }
#pragma unroll
        for (int e = 0; e < 4; ++e) { const size_t j = i + e * nth; if (j < NC) *(uint4*)(dst + j * 8) = pack8(a[e], b[e]); } }
    const float* ks = p.in[3] + (size_t)l * 8 * PAST * 32; bf16_t* KRS = (bf16_t*)(p.ws + WS_KRS);
    for (size_t i = gt; i < (size_t)8 * PAST * 32 / 8; i += nth) { const f32x4 a = __builtin_nontemporal_load((const f32x4*)(ks + i * 8)), b = __builtin_nontemporal_load((const f32x4*)(ks + i * 8 + 4));
        const size_t row = i >> 2, bb = row >> 12, key = row & 4095; *(uint4*)(KRS + (bb * KSS + key) * 32 + (i & 3) * 8) = pack8(a, b); }
}

__device__ __forceinline__ void hg_item(int it, int& tok0, int& nrows, int& b, int& h) {
    if (it < 1024) { const int sq = it >> 5, c = it & 31; b = sq >> 2; h = sq & 3; tok0 = b * SEQ + c * 64; nrows = 64; }
    else { const int si = it - 1024; b = si >> 2; h = si & 3; tok0 = TP + b * DSEQ; nrows = 32; }
}
__device__ __forceinline__ void hg_stage(bf16_t* dst, const bf16_t* Z, int tok0, int nrows, int col, int tid) {
#pragma unroll
    for (int i = 0; i < 2; ++i) { const int c = tid + 512 * i, row = c >> 4, seg = c & 15; uint4 v = make_uint4(0, 0, 0, 0);
        if (row < nrows) v = *(const uint4*)(Z + (size_t)(tok0 + row) * NZ + col + seg * 8);
        *(uint4*)(dst + row * 136 + seg * 8) = v; }
}
__device__ __forceinline__ void hg_store16(bf16_t* dst, const float (&x)[16]) {
    uint4 a, b; a.x = pk2(x[0], x[1]); a.y = pk2(x[2], x[3]); a.z = pk2(x[4], x[5]); a.w = pk2(x[6], x[7]); b.x = pk2(x[8], x[9]); b.y = pk2(x[10], x[11]); b.z = pk2(x[12], x[13]); b.w = pk2(x[14], x[15]);
    *(uint4*)dst = a; *(uint4*)(dst + 8) = b;
}
__device__ __forceinline__ void hgrn_pass1(unsigned char* smem, const Params& p, int l, int it) {
    const int tid = opaque_tid(), lane = tid & 63, w = tid >> 6, fr = lane & 15, fq = lane >> 4;
    int tok0, nrows, b, h; hg_item(it, tok0, nrows, b, h);
    const bf16_t* Z = (const bf16_t*)(p.ws + WS_Z);
    bf16_t* Zf = (bf16_t*)smem;
    bf16_t* Zi = Zf + 64 * 136;
    bf16_t* KdT = Zi + 64 * 136;
    bf16_t* VT = KdT + 128 * 72;
    float* tot = (float*)(VT + 128 * 72);
    hg_stage(Zf, Z, tok0, nrows, ZHF + h * 128, tid); hg_stage(Zi, Z, tok0, nrows, ZHI + h * 128, tid);
    __syncthreads();
    const int k = tid & 127, part = tid >> 7; const float lb = ((const float*)(p.ws + WS_LB))[l * 512 + h * 128 + k];
    float cs[16], kk[16], vv[16]; float run = 0.f;
#pragma unroll
    for (int i = 0; i < 16; ++i) { const int t = part * 16 + i;
        if (t < nrows) { const float sg = sigmoidf_(bf2f(Zf[t * 136 + k])); run += __logf(lb + (1.0f - lb) * sg + 1e-30f); kk[i] = (1.0f - lb) * (1.0f - sg); }
        else kk[i] = 0.f;
        vv[i] = bf2f(Zi[t * 136 + k]); cs[i] = run; }
    tot[part * 128 + k] = run;
    hg_store16(VT + k * 72 + part * 16, vv);
    __syncthreads();
    float pre = 0.f, bL = 0.f;
#pragma unroll
    for (int q = 0; q < 4; ++q) { const float tv = tot[q * 128 + k]; bL += tv; if (q < part) pre += tv; }
#pragma unroll
    for (int i = 0; i < 16; ++i) kk[i] = kk[i] * __expf(bL - (pre + cs[i]));
    hg_store16(KdT + k * 72 + part * 16, kk);
    if (part == 0) ((float*)(p.ws + WS_HD))[(size_t)it * 128 + k] = __expf(bL);
    __syncthreads();
    bf16x8 vf[2];
#pragma unroll
    for (int ks = 0; ks < 2; ++ks) vf[ks] = *(const bf16x8*)(VT + (16 * w + fr) * 72 + ks * 32 + fq * 8);
    bf16_t* HS = (bf16_t*)(p.ws + WS_HS) + (size_t)it * 16384;
#pragma unroll
    for (int nt = 0; nt < 8; ++nt) { f32x4 acc = {0.f, 0.f, 0.f, 0.f};
#pragma unroll
        for (int ks = 0; ks < 2; ++ks) { const bf16x8 kf = *(const bf16x8*)(KdT + (16 * nt + fr) * 72 + ks * 32 + fq * 8); acc = mfma16(kf, vf[ks], acc); }
        *(uint2*)(HS + (size_t)(16 * w + fr) * 128 + 16 * nt + 4 * fq) = make_uint2(pk2(acc[0], acc[1]), pk2(acc[2], acc[3])); }
    __syncthreads();
}
__device__ __forceinline__ void hgrn_scan(const Params& p, int l, int item) {
    const int tid = opaque_tid(), sq = item >> 4, vb = item & 15, v = vb * 8 + (tid >> 6), k0 = (tid & 63) * 2;
    bf16_t* HS = (bf16_t*)(p.ws + WS_HS); const float* HD = (const float*)(p.ws + WS_HD);
    if (sq < 32) { const int b = sq >> 2, h = sq & 3, it0 = sq * 32; float* outp = p.out + O_HSP + (size_t)((l * 8 + b) * 4 + h) * 16384;
        unsigned u[32]; f32x2 d[32];
#pragma unroll
        for (int c = 0; c < 32; ++c) { u[c] = *(const unsigned*)(HS + (size_t)(it0 + c) * 16384 + v * 128 + k0); d[c] = *(const f32x2*)(HD + (size_t)(it0 + c) * 128 + k0); }
        float r0 = 0.f, r1 = 0.f;
#pragma unroll
        for (int c = 0; c < 32; ++c) { *(unsigned*)(HS + (size_t)(it0 + c) * 16384 + v * 128 + k0) = pk2(r0, r1); r0 = d[c][0] * r0 + lo16(u[c]); r1 = d[c][1] * r1 + hi16(u[c]); }
        outp[(size_t)k0 * 128 + v] = r0; outp[(size_t)(k0 + 1) * 128 + v] = r1;
    } else { const int si = sq - 32, b = si >> 2, h = si & 3, it0 = 1024 + si; float* outp = p.out + O_HSS + (size_t)((l * 8 + b) * 4 + h) * 16384;
        const float* st = p.in[4] + (size_t)((l * 8 + b) * 4 + h) * 16384;
        float r0 = st[(size_t)k0 * 128 + v], r1 = st[(size_t)(k0 + 1) * 128 + v];
        bf16_t* hp = HS + (size_t)it0 * 16384 + v * 128 + k0; const unsigned u = *(const unsigned*)hp; const f32x2 d = *(const f32x2*)(HD + (size_t)it0 * 128 + k0);
        *(unsigned*)hp = pk2(r0, r1); r0 = d[0] * r0 + lo16(u); r1 = d[1] * r1 + hi16(u);
        outp[(size_t)k0 * 128 + v] = r0; outp[(size_t)(k0 + 1) * 128 + v] = r1; }
}
__device__ __forceinline__ void hgrn_pass3(unsigned char* smem, const Params& p, int l, int it) {
    const int tid = opaque_tid(), lane = tid & 63, w = tid >> 6, fr = lane & 15, fq = lane >> 4;
    int tok0, nrows, b, h; hg_item(it, tok0, nrows, b, h);
    const bf16_t* Z = (const bf16_t*)(p.ws + WS_Z);
    bf16_t* Qp = (bf16_t*)smem;
    bf16_t* Kp = Qp + 64 * 136;
    bf16_t* Qs = Kp + 64 * 136;
    bf16_t* Zi = Qs + 64 * 136;
    bf16_t* Zg = Zi + 64 * 136;
    bf16_t* VT = Zg + 64 * 136;
    bf16_t* Ab = VT + 128 * 72;
    float* tot = (float*)(Ab + 64 * 72);
    float* rss = tot + 512;
    const bf16_t* HS = (const bf16_t*)(p.ws + WS_HS) + (size_t)it * 16384;
    bf16x8 sf[4];
#pragma unroll
    for (int ks = 0; ks < 4; ++ks) sf[ks] = *(const bf16x8*)(HS + (size_t)(16 * w + fr) * 128 + ks * 32 + fq * 8);
    hg_stage(Qp, Z, tok0, nrows, ZHQ + h * 128, tid); hg_stage(Kp, Z, tok0, nrows, ZHF + h * 128, tid);
    hg_stage(Zi, Z, tok0, nrows, ZHI + h * 128, tid); hg_stage(Zg, Z, tok0, nrows, ZHG + h * 128, tid);
    __syncthreads();
    const int k = tid & 127, part = tid >> 7; const float lb = ((const float*)(p.ws + WS_LB))[l * 512 + h * 128 + k];
    float cs[16], kk[16], qv[16]; float run = 0.f;
    {   float vv[16];
#pragma unroll
        for (int i = 0; i < 16; ++i) { const int t = part * 16 + i;
            if (t < nrows) { const float sg = sigmoidf_(bf2f(Kp[t * 136 + k])); run += __logf(lb + (1.0f - lb) * sg + 1e-30f); kk[i] = (1.0f - lb) * (1.0f - sg); }
            else kk[i] = 0.f;
            qv[i] = bf2f(Qp[t * 136 + k]); vv[i] = bf2f(Zi[t * 136 + k]); cs[i] = run; }
        hg_store16(VT + k * 72 + part * 16, vv); }
    tot[part * 128 + k] = run;
    __syncthreads();
    float pre = 0.f; const float bmid = tot[k] + tot[128 + k];
#pragma unroll
    for (int q = 0; q < 4; ++q) if (q < part) pre += tot[q * 128 + k];
#pragma unroll
    for (int i = 0; i < 16; ++i) { const int t = part * 16 + i; const float bt = pre + cs[i];
        Qp[t * 136 + k] = f2bf(qv[i] * __expf(fminf(bt - bmid, 80.f))); Kp[t * 136 + k] = f2bf(kk[i] * __expf(fminf(bmid - bt, 80.f))); Qs[t * 136 + k] = f2bf(qv[i] * __expf(bt)); }
    __syncthreads();
    {   const int tm = w >> 1;
#pragma unroll
        for (int q = 0; q < 2; ++q) { const int sn = (w & 1) * 2 + q; f32x4 acc = {0.f, 0.f, 0.f, 0.f};
            if (sn <= tm) {
#pragma unroll
                for (int ks = 0; ks < 4; ++ks) { const bf16x8 a = *(const bf16x8*)(Qp + (16 * tm + fr) * 136 + ks * 32 + fq * 8), bb = *(const bf16x8*)(Kp + (16 * sn + fr) * 136 + ks * 32 + fq * 8); acc = mfma16(a, bb, acc); } }
#pragma unroll
            for (int j = 0; j < 4; ++j) { const int t = 16 * tm + 4 * fq + j, s2 = 16 * sn + fr; Ab[t * 72 + s2] = (s2 <= t && sn <= tm) ? f2bf(acc[j]) : (bf16_t)0; } }
    }
    __syncthreads();
    f32x4 o[4];
#pragma unroll
    for (int mt = 0; mt < 4; ++mt) o[mt] = (f32x4){0.f, 0.f, 0.f, 0.f};
#pragma unroll
    for (int ks = 0; ks < 2; ++ks) { const bf16x8 vf = *(const bf16x8*)(VT + (16 * w + fr) * 72 + ks * 32 + fq * 8);
#pragma unroll
        for (int mt = 0; mt < 4; ++mt) { const bf16x8 a = *(const bf16x8*)(Ab + (16 * mt + fr) * 72 + ks * 32 + fq * 8); o[mt] = mfma16(a, vf, o[mt]); } }
#pragma unroll
    for (int ks = 0; ks < 4; ++ks) {
#pragma unroll
        for (int mt = 0; mt < 4; ++mt) { const bf16x8 a = *(const bf16x8*)(Qs + (16 * mt + fr) * 136 + ks * 32 + fq * 8); o[mt] = mfma16(a, sf[ks], o[mt]); } }
#pragma unroll
    for (int mt = 0; mt < 4; ++mt)
#pragma unroll
        for (int j = 0; j < 4; ++j) { const float s2 = row16_sum(o[mt][j] * o[mt][j]);
            if (fr == 0) rss[(16 * mt + 4 * fq + j) * 8 + w] = s2; }
    __syncthreads();
    const float gn = p.in[14][l * 512 + h * 128 + 16 * w + fr];
#pragma unroll
    for (int mt = 0; mt < 4; ++mt)
#pragma unroll
        for (int j = 0; j < 4; ++j) { const int t = 16 * mt + 4 * fq + j;
            const f32x4 r0 = *(const f32x4*)(rss + t * 8), r1 = *(const f32x4*)(rss + t * 8 + 4);
            const float rs = rsqrtf((r0[0] + r0[1] + r0[2] + r0[3] + r1[0] + r1[1] + r1[2] + r1[3]) * (1.0f / 128.0f) + EPS);
            const float hg = bf2f(Zg[t * 136 + 16 * w + fr]);
            Qs[t * 136 + 16 * w + fr] = f2bf(o[mt][j] * rs * gn * hg * sigmoidf_(hg)); }
    __syncthreads();
    bf16_t* OC = (bf16_t*)(p.ws + WS_OCAT);
#pragma unroll
    for (int i = 0; i < 2; ++i) { const int c = tid + 512 * i, row = c >> 4, seg = c & 15;
        if (row < nrows) *(uint4*)(OC + (size_t)(tok0 + row) * 1536 + 512 + h * 128 + seg * 8) = *(const uint4*)(Qs + row * 136 + seg * 8); }
    __syncthreads();
}

__device__ __forceinline__ void cmlp_item(unsigned char* smem, const Params& p, int l, int item) {
    const int tid = opaque_tid(), lane = tid & 63, w = tid >> 6, fr = lane & 15, fq = lane >> 4;
    const int ch = item >> 2, g = item & 3; int tok0, nrows;
    if (ch < 128) { tok0 = ch * 128; nrows = 128; } else { tok0 = TP + (ch - 128) * DSEQ; nrows = 32; }
    const bf16_t* Z = (const bf16_t*)(p.ws + WS_Z);
    bf16_t* Vr = (bf16_t*)smem;
    bf16_t* VcT = Vr + 128 * 136;
    bf16_t* Wl = VcT + 128 * 136;
#pragma unroll
    for (int q = 0; q < 4; ++q) { const int c = tid + 512 * q, row = c >> 4, seg = c & 15; uint4 v = make_uint4(0, 0, 0, 0);
        if (row < nrows) v = *(const uint4*)(Z + (size_t)(tok0 + row) * NZ + ZCV + g * 128 + seg * 8);
        *(uint4*)(Vr + row * 136 + seg * 8) = v; }
    {   const int i = tid >> 2, j0 = (tid & 3) * 32; const float* wp = p.in[17] + ((size_t)(l * 4 + g) * 128 + i) * 128 + j0;
#pragma unroll
        for (int q = 0; q < 4; ++q) { f32x4 a = *(const f32x4*)(wp + q * 8), bb = *(const f32x4*)(wp + q * 8 + 4);
#pragma unroll
            for (int e = 0; e < 4; ++e) { if (j0 + q * 8 + e > i) a[e] = 0.f; if (j0 + q * 8 + 4 + e > i) bb[e] = 0.f; }
            *(uint4*)(Wl + i * 136 + j0 + q * 8) = pack8(a, bb); } }
    __syncthreads();
    {   const int c = tid & 127, part = tid >> 7;
#pragma unroll
        for (int q = 0; q < 4; ++q) { unsigned short e[8];
#pragma unroll
            for (int i = 0; i < 8; ++i) e[i] = Vr[(part * 32 + q * 8 + i) * 136 + c];
            uint4 o; o.x = e[0] | ((unsigned)e[1] << 16); o.y = e[2] | ((unsigned)e[3] << 16); o.z = e[4] | ((unsigned)e[5] << 16); o.w = e[6] | ((unsigned)e[7] << 16);
            *(uint4*)(VcT + c * 136 + part * 32 + q * 8) = o; } }
    __syncthreads();
    uint4 ur[4];
#pragma unroll
    for (int q = 0; q < 4; ++q) { const int c = tid + 512 * q, row = c >> 4, seg = c & 15; ur[q] = make_uint4(0, 0, 0, 0);
        if (row < nrows) ur[q] = *(const uint4*)(Z + (size_t)(tok0 + row) * NZ + ZCU + g * 128 + seg * 8); }
    const bool act = 16 * w < nrows;
    f32x4 acc[8];
    if (act) {
        bf16x8 af[4];
#pragma unroll
        for (int ks = 0; ks < 4; ++ks) af[ks] = *(const bf16x8*)(Wl + (16 * w + fr) * 136 + ks * 32 + fq * 8);
#pragma unroll
        for (int nt = 0; nt < 8; ++nt) { acc[nt] = (f32x4){0.f, 0.f, 0.f, 0.f};
#pragma unroll
            for (int ks = 0; ks < 4; ++ks) { const bf16x8 bb = *(const bf16x8*)(VcT + (16 * nt + fr) * 136 + ks * 32 + fq * 8); acc[nt] = mfma16(af[ks], bb, acc[nt]); } }
    }
#pragma unroll
    for (int q = 0; q < 4; ++q) { const int c = tid + 512 * q, row = c >> 4, seg = c & 15; *(uint4*)(Vr + row * 136 + seg * 8) = ur[q]; }
    __syncthreads();
    if (act) {
        float bias[4];
#pragma unroll
        for (int j = 0; j < 4; ++j) bias[j] = p.in[18][(size_t)(l * 4 + g) * 128 + 16 * w + 4 * fq + j];
#pragma unroll
        for (int nt = 0; nt < 8; ++nt)
#pragma unroll
            for (int j = 0; j < 4; ++j) { bf16_t* e = Vr + (16 * w + 4 * fq + j) * 136 + 16 * nt + fr; *e = f2bf(bf2f(*e) * (acc[nt][j] + bias[j])); }
    }
    __syncthreads();
    bf16_t* OC = (bf16_t*)(p.ws + WS_OCAT);
#pragma unroll
    for (int q = 0; q < 4; ++q) { const int c = tid + 512 * q, row = c >> 4, seg = c & 15;
        if (row < nrows) *(uint4*)(OC + (size_t)(tok0 + row) * 1536 + 1024 + g * 128 + seg * 8) = *(const uint4*)(Vr + row * 136 + seg * 8); }
    __syncthreads();
}

typedef unsigned u32x4 __attribute__((ext_vector_type(4)));
typedef unsigned u32x2 __attribute__((ext_vector_type(2)));
__device__ __forceinline__ void attn_item(unsigned char* smem, const Params& p, int item) {
    const int tid = opaque_tid(), lane = tid & 63, w = tid >> 6, fr = lane & 15, fq = lane >> 4;
    const bf16_t* Qb = (const bf16_t*)(p.ws + WS_Q);
    const int x = item - 64, i = 7 - (x >> 6), bh = x & 63, b = bh >> 3, h = bh & 7;
    const int qtok0 = b * SEQ + i * 256, nks = 2 * i + 2, wlim = 4 * i + (w >> 1) + 1;
    const bf16_t* kn = (const bf16_t*)(p.ws + WS_KN) + (size_t)b * SEQ * 512 + h * 64; const bf16_t* kr = (const bf16_t*)(p.ws + WS_KRB) + (size_t)b * SEQ * 32;
    const bf16_t* vt = (const bf16_t*)(p.ws + WS_VT) + (size_t)(b * 512 + h * 64) * SEQ;
    LAS unsigned char* L = (LAS unsigned char*)smem;
    constexpr int KSB = 128 * 208, VSB = 64 * 272, BUFB = KSB + VSB;
    bf16x8 qf[2][3];
#pragma unroll
    for (int qt = 0; qt < 2; ++qt) { const bf16_t* qp = Qb + (size_t)(qtok0 + 32 * w + 16 * qt + fr) * 768 + h * 96;
#pragma unroll
        for (int ks = 0; ks < 3; ++ks) qf[qt][ks] = *(const bf16x8*)(qp + ks * 32 + fq * 8); }
    f32x4 o[2][4]; float mrow[2], lrow[2];
#pragma unroll
    for (int qt = 0; qt < 2; ++qt) { mrow[qt] = -1e30f; lrow[qt] = 0.f;
#pragma unroll
        for (int d = 0; d < 4; ++d) o[qt][d] = (f32x4){0.f, 0.f, 0.f, 0.f}; }
    u32x4 rk0, rk1, rr, rv0, rv1;
    const int kr0 = tid >> 3, ksg = tid & 7, rrw = tid >> 2, rsg = tid & 3, vr0 = tid >> 4, vsg = tid & 15;
    const unsigned wk0 = kr0 * 208 + ksg * 16, wk1 = (kr0 + 64) * 208 + ksg * 16, wrr = rrw * 208 + 128 + rsg * 16, wv0 = KSB + vr0 * 272 + vsg * 16, wv1 = KSB + (vr0 + 32) * 272 + vsg * 16;
#define ATT_LOAD(k0) do { rk0 = *(const u32x4*)(kn + (size_t)((k0) + kr0) * 512 + ksg * 8); rk1 = *(const u32x4*)(kn + (size_t)((k0) + kr0 + 64) * 512 + ksg * 8); \
        rr = *(const u32x4*)(kr + (size_t)((k0) + rrw) * 32 + rsg * 8); rv0 = *(const u32x4*)(vt + (size_t)vr0 * SEQ + (k0) + vsg * 8); rv1 = *(const u32x4*)(vt + (size_t)(vr0 + 32) * SEQ + (k0) + vsg * 8); } while (0)
#define ATT_STORE(buf) do { LAS unsigned char* B_ = L + (buf) * BUFB; *(LAS u32x4*)(B_ + wk0) = rk0; *(LAS u32x4*)(B_ + wk1) = rk1; *(LAS u32x4*)(B_ + wrr) = rr; *(LAS u32x4*)(B_ + wv0) = rv0; *(LAS u32x4*)(B_ + wv1) = rv1; } while (0)
    ATT_LOAD(0); ATT_STORE(0);
    __syncthreads();
    if (nks > 1) ATT_LOAD(128);
    if (__builtin_amdgcn_readfirstlane(tid) >= 256) __builtin_amdgcn_s_setprio(1);
    for (int ks2 = 0; ks2 < nks; ++ks2) {
        if (ks2 + 1 < nks) ATT_STORE((ks2 + 1) & 1);
        if (ks2 + 2 < nks) ATT_LOAD((ks2 + 2) * 128);
        if (2 * ks2 < wlim) {
            const LAS unsigned char* KB = L + (ks2 & 1) * BUFB; const LAS unsigned char* VB = KB + KSB;
            f32x4 s[2][8];
#pragma unroll
            for (int nt = 0; nt < 8; ++nt) { s[0][nt] = (f32x4){0.f, 0.f, 0.f, 0.f}; s[1][nt] = (f32x4){0.f, 0.f, 0.f, 0.f};
#pragma unroll
                for (int ks = 0; ks < 3; ++ks) { const bf16x8 kf = *(const LAS bf16x8*)(KB + (16 * nt + fr) * 208 + ks * 64 + fq * 16);
                    s[0][nt] = mfma16(kf, qf[0][ks], s[0][nt]); s[1][nt] = mfma16(kf, qf[1][ks], s[1][nt]); } }
            if (2 * ks2 + 1 >= wlim) {
#pragma unroll
                for (int nt = 4; nt < 8; ++nt) { s[0][nt] = (f32x4){-1e30f, -1e30f, -1e30f, -1e30f}; s[1][nt] = (f32x4){-1e30f, -1e30f, -1e30f, -1e30f}; } }
            bf16x8 pb[2][4];
#pragma unroll
            for (int qt = 0; qt < 2; ++qt) {
                float mx = -1e30f;
#pragma unroll
                for (int nt = 0; nt < 8; ++nt) mx = fmaxf(mx, fmaxf(fmaxf(s[qt][nt][0], s[qt][nt][1]), fmaxf(s[qt][nt][2], s[qt][nt][3])));
                mx = xr32_max(xr16_max(mx));
                float mn = mrow[qt], al = 1.0f;
                if (__builtin_amdgcn_ballot_w64(mx - mn > 8.0f) != 0ull) { mn = fmaxf(mn, mx); al = __builtin_amdgcn_exp2f(mrow[qt] - mn); mrow[qt] = mn;
#pragma unroll
                    for (int dn = 0; dn < 4; ++dn) o[qt][dn] = o[qt][dn] * al; }
                float ps = 0.f;
#pragma unroll
                for (int nt = 0; nt < 8; ++nt)
#pragma unroll
                    for (int j = 0; j < 4; ++j) { const float pv = __builtin_amdgcn_exp2f(s[qt][nt][j] - mn); s[qt][nt][j] = pv; ps += pv; }
                lrow[qt] = lrow[qt] * al + ps;
#pragma unroll
                for (int t = 0; t < 4; ++t) { const u32x4 u = {pk2(s[qt][2 * t][0], s[qt][2 * t][1]), pk2(s[qt][2 * t][2], s[qt][2 * t][3]), pk2(s[qt][2 * t + 1][0], s[qt][2 * t + 1][1]), pk2(s[qt][2 * t + 1][2], s[qt][2 * t + 1][3])};
                    pb[qt][t] = __builtin_bit_cast(bf16x8, u); }
            }
#pragma unroll
            for (int t = 0; t < 4; ++t)
#pragma unroll
                for (int dn = 0; dn < 4; ++dn) { const LAS unsigned char* vp = VB + (16 * dn + fr) * 272 + (32 * t + 4 * fq) * 2;
                    const u32x2 v0 = *(const LAS u32x2*)vp, v1 = *(const LAS u32x2*)(vp + 32); const u32x4 u = {v0[0], v0[1], v1[0], v1[1]}; const bf16x8 vf = __builtin_bit_cast(bf16x8, u);
                    o[0][dn] = mfma16(vf, pb[0][t], o[0][dn]); o[1][dn] = mfma16(vf, pb[1][t], o[1][dn]); }
        }
        __syncthreads();
    }
#undef ATT_LOAD
#undef ATT_STORE
    __builtin_amdgcn_s_setprio(0);
    bf16_t* OC = (bf16_t*)(p.ws + WS_OCAT);
#pragma unroll
    for (int qt = 0; qt < 2; ++qt) { float ls = lrow[qt]; ls = xr32_sum(xr16_sum(ls)); const float inv = 1.0f / ls; const int r = 32 * w + 16 * qt + fr;
#pragma unroll
        for (int dn = 0; dn < 4; ++dn) { const f32x4 v = o[qt][dn] * inv; *(uint2*)(OC + (size_t)(qtok0 + r) * 1536 + h * 64 + 16 * dn + 4 * fq) = make_uint2(pk2(v[0], v[1]), pk2(v[2], v[3])); } }
}

__device__ __forceinline__ void attn_sample_item(unsigned char* smem, const Params& p, int item) {
    const int tid = opaque_tid(), lane = tid & 63, w = tid >> 6, fr = lane & 15, fq = lane >> 4;
    const int b = item >> 3, h = item & 7, qtok0 = TP + b * DSEQ;
    const bf16_t* kn = (const bf16_t*)(p.ws + WS_KNS) + (size_t)b * KSS * 512 + h * 64; const bf16_t* kr = (const bf16_t*)(p.ws + WS_KRS) + (size_t)b * KSS * 32;
    const bf16_t* vt = (const bf16_t*)(p.ws + WS_VTS) + (size_t)(b * 512 + h * 64) * KSS; const bf16_t* Qb = (const bf16_t*)(p.ws + WS_Q);
    bf16x8 qf[2][3];
#pragma unroll
    for (int qt = 0; qt < 2; ++qt) { const bf16_t* qp = Qb + (size_t)(qtok0 + 16 * qt + fr) * 768 + h * 96;
#pragma unroll
        for (int ks = 0; ks < 3; ++ks) qf[qt][ks] = *(const bf16x8*)(qp + ks * 32 + fq * 8); }
    f32x4 o[2][4]; float mrow[2], lrow[2];
#pragma unroll
    for (int qt = 0; qt < 2; ++qt) { mrow[qt] = -1e30f; lrow[qt] = 0.f;
#pragma unroll
        for (int i = 0; i < 4; ++i) o[qt][i] = (f32x4){0.f, 0.f, 0.f, 0.f}; }
    for (int kt = w; kt < 65; kt += 8) {
        const int k0 = kt * 64;
        f32x4 s[2][4];
#pragma unroll
        for (int nt = 0; nt < 4; ++nt) { s[0][nt] = (f32x4){0.f, 0.f, 0.f, 0.f}; s[1][nt] = (f32x4){0.f, 0.f, 0.f, 0.f};
            const size_t key = (size_t)(k0 + 16 * nt + fr);
#pragma unroll
            for (int ks = 0; ks < 3; ++ks) { const bf16x8 kf = (ks < 2) ? *(const bf16x8*)(kn + key * 512 + ks * 32 + fq * 8) : *(const bf16x8*)(kr + key * 32 + fq * 8);
                s[0][nt] = mfma16(kf, qf[0][ks], s[0][nt]); s[1][nt] = mfma16(kf, qf[1][ks], s[1][nt]); } }
        if (kt == 64) {
#pragma unroll
            for (int nt = 0; nt < 4; ++nt)
#pragma unroll
                for (int j = 0; j < 4; ++j) if (k0 + 16 * nt + 4 * fq + j >= PAST + DSEQ) { s[0][nt][j] = -1e30f; s[1][nt][j] = -1e30f; } }
        bf16x8 pb[2][2];
#pragma unroll
        for (int qt = 0; qt < 2; ++qt) {
            float mx = -1e30f;
#pragma unroll
            for (int nt = 0; nt < 4; ++nt) mx = fmaxf(mx, fmaxf(fmaxf(s[qt][nt][0], s[qt][nt][1]), fmaxf(s[qt][nt][2], s[qt][nt][3])));
            mx = xr32_max(xr16_max(mx));
            float mn = mrow[qt], al = 1.0f;
            if (__builtin_amdgcn_ballot_w64(mx - mn > 8.0f) != 0ull) { mn = fmaxf(mn, mx); al = __builtin_amdgcn_exp2f(mrow[qt] - mn); mrow[qt] = mn;
#pragma unroll
                for (int dn = 0; dn < 4; ++dn) o[qt][dn] = o[qt][dn] * al; }
            float ps = 0.f;
#pragma unroll
            for (int nt = 0; nt < 4; ++nt)
#pragma unroll
                for (int j = 0; j < 4; ++j) { const float pv = __builtin_amdgcn_exp2f(s[qt][nt][j] - mn); s[qt][nt][j] = pv; ps += pv; }
            lrow[qt] = lrow[qt] * al + ps;
#pragma unroll
            for (int t = 0; t < 2; ++t) { const u32x4 u = {pk2(s[qt][2 * t][0], s[qt][2 * t][1]), pk2(s[qt][2 * t][2], s[qt][2 * t][3]), pk2(s[qt][2 * t + 1][0], s[qt][2 * t + 1][1]), pk2(s[qt][2 * t + 1][2], s[qt][2 * t + 1][3])};
                pb[qt][t] = __builtin_bit_cast(bf16x8, u); }
        }
#pragma unroll
        for (int t = 0; t < 2; ++t)
#pragma unroll
            for (int dn = 0; dn < 4; ++dn) { const bf16_t* vp = vt + (size_t)(16 * dn + fr) * KSS + k0 + 32 * t + 4 * fq;
                const u32x2 v0 = *(const u32x2*)vp, v1 = *(const u32x2*)(vp + 16); const u32x4 u = {v0[0], v0[1], v1[0], v1[1]}; const bf16x8 vf = __builtin_bit_cast(bf16x8, u);
                o[0][dn] = mfma16(vf, pb[0][t], o[0][dn]); o[1][dn] = mfma16(vf, pb[1][t], o[1][dn]); }
    }
    float* Ow = (float*)smem; float* Mw = Ow + 8 * 32 * 68; float* Lw = Mw + 256;
#pragma unroll
    for (int qt = 0; qt < 2; ++qt) { float ls = lrow[qt]; ls = xr32_sum(xr16_sum(ls));
        if (fq == 0) { Mw[w * 32 + 16 * qt + fr] = mrow[qt]; Lw[w * 32 + 16 * qt + fr] = ls; }
#pragma unroll
        for (int dn = 0; dn < 4; ++dn) *(f32x4*)(Ow + (size_t)(w * 32 + 16 * qt + fr) * 68 + 16 * dn + 4 * fq) = o[qt][dn]; }
    __syncthreads();
    {   const int q = tid >> 4, d0 = (tid & 15) * 4; float M = -1e30f;
#pragma unroll
        for (int ww = 0; ww < 8; ++ww) M = fmaxf(M, Mw[ww * 32 + q]);
        f32x4 acc = {0.f, 0.f, 0.f, 0.f}; float L = 0.f;
#pragma unroll
        for (int ww = 0; ww < 8; ++ww) { const float sc = __builtin_amdgcn_exp2f(Mw[ww * 32 + q] - M); L += sc * Lw[ww * 32 + q]; acc = acc + *(const f32x4*)(Ow + (size_t)(ww * 32 + q) * 68 + d0) * sc; }
        const float inv = 1.0f / L; acc = acc * inv;
        *(uint2*)((bf16_t*)(p.ws + WS_OCAT) + (size_t)(qtok0 + q) * 1536 + h * 64 + d0) = make_uint2(pk2(acc[0], acc[1]), pk2(acc[2], acc[3])); }
    __syncthreads();
}

#define XB_TMO      128
#define XB_XCNT(j)  (256  + 64 * (j))
#define XB_XSUB(j)  (1280 + 64 * (j))
#define XB_XGEN(j)  (2304 + 64 * (j))
#define XB_TOP      3328
#define XB_TOPGEN   3392
#define XB_SPIN_CAP (1u << 20)
__device__ __forceinline__ unsigned xb_ld(unsigned* p)              { return __hip_atomic_load(p, __ATOMIC_RELAXED, __HIP_MEMORY_SCOPE_AGENT); }
__device__ __forceinline__ unsigned xb_add(unsigned* p, unsigned v) { return __hip_atomic_fetch_add(p, v, __ATOMIC_RELAXED, __HIP_MEMORY_SCOPE_AGENT); }
__device__ __forceinline__ unsigned xb_xcc_id() { return (unsigned)__builtin_amdgcn_s_getreg((3 << 11) | 20) & 0xFu; }
#define XB_SPIN(cond, bar) do { unsigned _sp = 0; while (cond) { __builtin_amdgcn_s_sleep(1); \
    if ((++_sp & 255u) == 0u) { if (xb_ld(&(bar)[XB_TMO])) break; if (_sp > XB_SPIN_CAP) { atomicAdd(&(bar)[XB_TMO], 1u); break; } } } } while (0)
struct XcdBarrier { unsigned* bar; unsigned x; volatile LAS unsigned* st; };
__device__ __forceinline__ XcdBarrier xcd_barrier_post(unsigned* bar, volatile LAS unsigned* st) {
    XcdBarrier b; b.bar = bar; b.x = xb_xcc_id(); b.st = st;
    if (threadIdx.x == 0) (void)xb_add(&bar[XB_XCNT(b.x)], 1u);
    return b;
}
__device__ __forceinline__ void xcd_barrier_complete(unsigned* bar, unsigned x, unsigned& nloc, unsigned& nx) {
    const unsigned G = gridDim.x * gridDim.y * gridDim.z;
    unsigned sum, cnt, mine, sp = 0u;
    for (;;) {
        sum = 0u; cnt = 0u; mine = 0u;
#pragma unroll
        for (unsigned j = 0; j < 16; ++j) { const unsigned c = xb_ld(&bar[XB_XCNT(j)]); sum += c; cnt += (c > 0u) ? 1u : 0u; mine = (j == x) ? c : mine; }
        if (sum == G) break;
        __builtin_amdgcn_s_sleep(1);
        if ((++sp & 255u) == 0u) { if (xb_ld(&bar[XB_TMO])) break; if (sp > XB_SPIN_CAP) { atomicAdd(&bar[XB_TMO], 1u); break; } }
    }
    nloc = mine > 0u ? mine : 1u; nx = cnt > 0u ? cnt : 1u;
}
__device__ __forceinline__ void xcd_barrier(const XcdBarrier& b) {
    asm volatile("s_waitcnt vmcnt(0)" ::: "memory");
    __syncthreads();
    if (threadIdx.x == 0) {
        unsigned* bar = b.bar;
        __builtin_amdgcn_s_waitcnt(0);
        unsigned nloc = b.st[0], nx = b.st[1];
        if (nloc == 0u) { xcd_barrier_complete(bar, b.x, nloc, nx); b.st[0] = nloc; b.st[1] = nx; }
        const unsigned old = xb_add(&bar[XB_XSUB(b.x)], 1u);
        const unsigned gen = old / nloc;
        if (old + 1u == (gen + 1u) * nloc) {
            __builtin_amdgcn_fence(__ATOMIC_RELEASE, "agent");
            asm volatile("s_waitcnt vmcnt(0)" ::: "memory");
            const unsigned og = xb_add(&bar[XB_TOP], 1u);
            const unsigned tg = og / nx;
            if (og + 1u == (tg + 1u) * nx) xb_add(&bar[XB_TOPGEN], 1u);
            else XB_SPIN(xb_ld(&bar[XB_TOPGEN]) == tg, bar);
            __builtin_amdgcn_fence(__ATOMIC_ACQUIRE, "agent");
            xb_add(&bar[XB_XGEN(b.x)], 1u);
            asm volatile("s_waitcnt vmcnt(0)" ::: "memory");
        } else {
            XB_SPIN(xb_ld(&bar[XB_XGEN(b.x)]) == gen, bar);
            __builtin_amdgcn_fence(__ATOMIC_ACQUIRE, "agent");
            asm volatile("s_waitcnt vmcnt(0)" ::: "memory");
        }
    }
    __syncthreads();
}

__device__ __forceinline__ void prologue(unsigned char* smem, const Params& p) {
    const size_t gt = (size_t)blockIdx.x * 512 + opaque_tid();
    if (gt < 2080 * 16) { const int pidx = (int)(gt >> 4), i = (int)(gt & 15); const float pos = (float)(pidx < SEQ ? pidx : PAST + pidx - SEQ);
        const float inv = 1.0f / powf(10000.0f, (float)i / 16.0f); float sn, cs; sincosf(pos * inv, &sn, &cs);
        float* rp = (float*)(p.ws + WS_ROPE) + gt * 2; rp[0] = cs; rp[1] = sn; }
    if (gt < 512) { const float* hb = p.in[13]; const float a0 = hb[gt], a1 = hb[512 + gt], a2 = hb[1024 + gt], a3 = hb[1536 + gt]; const float mx = fmaxf(fmaxf(a0, a1), fmaxf(a2, a3));
        const float e0 = expf(a0 - mx), e1 = expf(a1 - mx), e2 = expf(a2 - mx), e3 = expf(a3 - mx), inv = 1.0f / (e0 + e1 + e2 + e3);
        float* lb = (float*)(p.ws + WS_LB); lb[gt] = 0.f; lb[512 + gt] = e1 * inv; lb[1024 + gt] = (e1 + e2) * inv; lb[1536 + gt] = (e1 + e2 + e3) * inv; }
    ln_rows(p.in[0], p.in[1], p.out + O_YP, (bf16_t*)(p.ws + WS_XB), p.in[5], p.in[6], nullptr, true, true);
    conv_layer(smem, p, 0);
}

template <int KSEL> __device__ __forceinline__ void run_phase(unsigned char* smem, const Params& p, int ph) {
    if (ph == 0) { if (KSEL < 0 || KSEL == 10) prologue(smem, p); return; }
    const int rep = ph >= 1000 ? 1 : 0; ph = ph % 1000; const int l = (ph - 1) / 10, k = (KSEL >= 20) ? 2 : (KSEL >= 0 && KSEL < 10) ? KSEL : (ph - 1) % 10;
    if (KSEL == 10) return;
    const bf16_t* W = (const bf16_t*)(p.ws + WS_WT);
    bf16_t* Z = (bf16_t*)(p.ws + WS_Z); bf16_t* XB = (bf16_t*)(p.ws + WS_XB); bf16_t* OC = (bf16_t*)(p.ws + WS_OCAT);
    float* X = p.out + O_YP; float* ST = (float*)(p.ws + WS_ST);
    const int G = gridDim.x, bid = blockIdx.x;
    switch (k) {
    case 0: { EpiZ e; e.Z = Z; run_gemm(smem, XB, 1024, W + W_IN, 1024, TT, NZ, 1024, 0, e); } break;
    case 1: {
        rowops(p, l); cache_conv(p, l);
        for (int it = bid; it < 1056; it += G) hgrn_pass1(smem, p, l, it);
    } break;
    case 2: {
        if (KSEL < 20 || KSEL == 20) { EpiQ e; e.Q = (bf16_t*)(p.ws + WS_Q); e.rope = (const float*)(p.ws + WS_ROPE); run_gemm(smem, Z + ZCQ, NZ, W + W_UQ, 256, TT, 768, 256, 0, e); }
        {   EpiKV4 e; e.kn0.KN = (bf16_t*)(p.ws + WS_KN); e.kn0.KNS = (bf16_t*)(p.ws + WS_KNS); e.kn0.mode = 0; e.kn1.KN = nullptr; e.kn1.KNS = e.kn0.KNS; e.kn1.mode = 1;
            e.vt0.VT = (bf16_t*)(p.ws + WS_VT); e.vt0.VTS = (bf16_t*)(p.ws + WS_VTS); e.vt0.mode = 0; e.vt1.VT = nullptr; e.vt1.VTS = e.vt0.VTS; e.vt1.mode = 1;
            int Kop = 256; asm volatile("" : "+s"(Kop));
            pg8::Gemm g; g.A = (const bf16_t*)p.ws; g.Bt = (const bf16_t*)p.ws; g.M = 0; g.N = 0; g.K = Kop; g.lda = 256; g.ldb = 256;
            const long oW = (long)(WS_WT + W_UKV * 2), oWv = oW + 512 * 256 * 2, oC = (long)WS_CKVN, oX = (long)WS_XB;
            KV4Order S; S.G = G; S.c = bid; S.oW = oW; S.oWv = oWv; S.oC = oC; S.oX = oX;
            pg8::gemm_phase<EpiKV4, KV4Order>((LAS unsigned char*)smem, g, S, e);
            __syncthreads(); }
        if (KSEL < 20 || KSEL == 25) for (int it = bid; it < 544; it += G) cmlp_item(smem, p, l, it);
#ifndef NO_SCAN
        if (KSEL < 20 || KSEL == 25) for (int it = bid; it < 1024; it += G) hgrn_scan(p, l, it);
#endif
    } break;
    case 3: {
        unsigned* ctr = (unsigned*)(p.ws + WS_CTL) + l; int* sitem = (int*)(smem + LDS_BYTES - 16);
        int nxt = 0; if (threadIdx.x == 0) nxt = (int)atomicAdd(ctr, 1u);
        for (;;) {
            if (threadIdx.x == 0) *sitem = nxt;
            __syncthreads(); const int it = *sitem;
            if (it >= 576 + 1056) break;
            if (threadIdx.x == 0) nxt = (int)atomicAdd(ctr, 1u);
            if (it < 64) attn_sample_item(smem, p, it); else if (it < 576) attn_item(smem, p, it); else hgrn_pass3(smem, p, l, it - 576);
        }
    } break;
    case 4: { EpiMerge e; e.Mo = XB; e.Z = Z; run_gemm(smem, OC, 1536, W + W_CAT, 1536, TP, 1024, 1536, 0, e); skinny_gemm<3, 1>(smem, p, OC, 1536, W + W_CAT, 1536, 512); } break;
    case 5: { EpiRes e; e.X = X; e.ST = l ? ST : nullptr; e.G = p.in[27] + (l ? l - 1 : 0) * 1024; e.B = p.in[28] + (l ? l - 1 : 0) * 1024; run_gemm(smem, XB, 1024, W + W_O, 1024, TP, 1024, 1024, 0, e); skinny_gemm<1, 0>(smem, p, XB, 1024, W + W_O, 1024, 1024, e.ST, e.G, e.B); } break;
    case 6: ln_rows(X, X + (size_t)TP * 1024, X, XB, p.in[23] + l * 1024, p.in[24] + l * 1024, ST, false); break;
    case 7: { EpiUp e; e.H = Z; run_gemm(smem, XB, 1024, W + W_UP, 1024, TT, 5632, 1024, 0, e); } break;
    case 8: { EpiRes e; e.X = X; e.ST = ST; e.G = p.in[23] + l * 1024; e.B = p.in[24] + l * 1024; run_gemm(smem, Z, DFF, W + W_DN, DFF, TP, 1024, DFF, 0, e); skinny_gemm<1, 0>(smem, p, Z, DFF, W + W_DN, DFF, DFF, e.ST, e.G, e.B); } break;
    case 9: { ln_rows(X, X + (size_t)TP * 1024, X, XB, p.in[27] + l * 1024, p.in[28] + l * 1024, ST, l + 1 == DEPTH); if (l + 1 < DEPTH) conv_layer(smem, p, l + 1); } break;
    }
}

__global__ void __launch_bounds__(512, 2) fwd_megakernel(Params p) {
    extern __shared__ __attribute__((aligned(16))) unsigned char shm[];
    volatile LAS unsigned* st = (volatile LAS unsigned*)(LAS unsigned char*)(shm + LDS_BYTES - 32);
    if (threadIdx.x == 0) { st[0] = 0u; st[1] = 0u; }
    __syncthreads();
    const XcdBarrier xb = xcd_barrier_post((unsigned*)(p.ws + WS_BAR), st);
    for (int ph = p.ph_lo; ph < p.ph_hi; ++ph) {
        run_phase<-1>(shm, p, ph);
        if (ph + 1 < p.ph_hi) { if (p.ph_lo < 0) cg::this_grid().sync();
            xcd_barrier(xb); }
    }
}
#ifdef TESTK
template <int KS> __global__ void __launch_bounds__(512, 2) test_k(Params p) { extern __shared__ __attribute__((aligned(16))) unsigned char shm[]; run_phase<KS>(shm, p, p.ph_lo); }
template __global__ void test_k<0>(Params); template __global__ void test_k<1>(Params); template __global__ void test_k<2>(Params); template __global__ void test_k<3>(Params);
template __global__ void test_k<4>(Params); template __global__ void test_k<5>(Params); template __global__ void test_k<6>(Params); template __global__ void test_k<7>(Params);
template __global__ void test_k<8>(Params); template __global__ void test_k<9>(Params); template __global__ void test_k<10>(Params); template __global__ void test_k<20>(Params); template __global__ void test_k<21>(Params); template __global__ void test_k<22>(Params); template __global__ void test_k<23>(Params); template __global__ void test_k<24>(Params); template __global__ void test_k<25>(Params);
#endif
extern "C" void kernel_launch(void* const* d_in, const int* in_sizes, int n_in, void* d_out, int out_size, void* d_ws, size_t ws_size, hipStream_t stream) {
    static int grid = 0;
    if (grid == 0) {
        int dev = 0, cus = 0, per_cu = 0;
        hipGetDevice(&dev); hipDeviceGetAttribute(&cus, hipDeviceAttributeMultiprocessorCount, dev);
        hipFuncSetAttribute((const void*)fwd_megakernel, hipFuncAttributeMaxDynamicSharedMemorySize, LDS_BYTES);
        hipOccupancyMaxActiveBlocksPerMultiprocessor(&per_cu, (const void*)fwd_megakernel, 512, LDS_BYTES);
        (void)hipGetLastError();
        if (per_cu < 1) per_cu = 1;
        grid = cus;
        if (ws_size < WS_END) { fprintf(stderr, "kernel_launch: workspace too small: %zu < %zu\n", ws_size, (size_t)WS_END); grid = -1; }
    }
    if (grid < 0) return;
    (void)hipMemsetAsync((char*)d_ws + WS_CTL, 0, 32768, stream);
    Params p{};
    for (int i = 0; i < 29; ++i) p.in[i] = (const float*)d_in[i];
    p.out = (float*)d_out; p.ws = (unsigned char*)d_ws;
#ifndef NPH_RUN
#define NPH_RUN (1 + 10 * DEPTH)
#endif
    const int NPH = NPH_RUN;
#if ONE_LAUNCH
    p.ph_lo = 0; p.ph_hi = NPH;
    void* args[] = {&p};
    hipError_t e = hipLaunchCooperativeKernel((const void*)fwd_megakernel, dim3(grid), dim3(512), args, LDS_BYTES, stream);
    if (e != hipSuccess) fprintf(stderr, "cooperative launch failed: %s (grid %d)\n", hipGetErrorString(e), grid);
#else
    for (int ph = 0; ph < NPH; ++ph) { p.ph_lo = ph; p.ph_hi = ph + 1; hipLaunchKernelGGL(fwd_megakernel, dim3(grid), dim3(512), LDS_BYTES, stream, p); }
#endif
}
```

```cpp
#include <hip/hip_runtime.h>
#include <hip/hip_cooperative_groups.h>
#include <stdint.h>
#include <stdio.h>
namespace cg = cooperative_groups;

#ifndef ONE_LAUNCH
#define ONE_LAUNCH 1
#endif

typedef unsigned short bf16_t;
typedef short bf16x8 __attribute__((ext_vector_type(8)));
typedef float f32x4 __attribute__((ext_vector_type(4)));
typedef float f32x2 __attribute__((ext_vector_type(2)));
#define LAS __attribute__((address_space(3)))

constexpr int DM = 1024, TP = 16384, TS = 256, TT = TP + TS, DEPTH = 4, NZ = 6912;
constexpr int SEQ = 2048, DSEQ = 32, PAST = 4096, KSS = 4160;
constexpr int DFF = 2816;
constexpr int ZCQ = 0, ZCKV = 256, ZHQ = 512, ZHF = 1024, ZHI = 1536, ZHG = 2048, ZCU = 2560, ZCV = 3072, ZGA = 3584, ZGB = 4608, ZGC = 5632, ZKR = 6656;
constexpr float EPS = 1e-5f;
constexpr float ALPHA = 1.681792830507429f;
constexpr float QSCALE = 0.10206207261596577f * 1.4426950408889634f;
constexpr size_t O_YP = 0, O_YS = 16777216, O_CKVP = 17039360, O_KRP = 33816576, O_HSP = 35913728, O_CKVS = 38010880, O_KRS = 38273024, O_HSS = 38305792, O_VS = 40402944;
constexpr size_t W_IN = 0, W_UQ = W_IN + (size_t)NZ * 1024, W_UKV = W_UQ + 768 * 256, W_CAT = W_UKV + 1024 * 256, W_O = W_CAT + 1024 * 1536, W_UP = W_O + 1024 * 1024,
                 W_DN = W_UP + (size_t)5632 * 1024, W_END = W_DN + (size_t)1024 * DFF;
constexpr size_t al(size_t x) { return (x + 255) & ~(size_t)255; }
constexpr size_t WS_CTL = 0, WS_BAR = 4096, WS_ROPE = 32768, WS_LB = al(WS_ROPE + 2080 * 16 * 8), WS_WT = al(WS_LB + 4 * 512 * 4), WS_XB = al(WS_WT + W_END * 2),
                 WS_Z = al(WS_XB + (size_t)TT * 1024 * 2), WS_Q = al(WS_Z + (size_t)TT * NZ * 2), WS_KN = al(WS_Q + (size_t)TT * 768 * 2), WS_VT = al(WS_KN + (size_t)TP * 512 * 2),
                 WS_KRB = al(WS_VT + (size_t)TP * 512 * 2), WS_KNS = al(WS_KRB + (size_t)TP * 32 * 2), WS_VTS = al(WS_KNS + (size_t)8 * KSS * 512 * 2),
                 WS_KRS = al(WS_VTS + (size_t)8 * 512 * KSS * 2), WS_OCAT = al(WS_KRS + (size_t)8 * KSS * 32 * 2), WS_HS = al(WS_OCAT + (size_t)TT * 1536 * 2),
                 WS_HD = al(WS_HS + (size_t)1056 * 16384 * 2), WS_ST = al(WS_HD + (size_t)1056 * 128 * 4), WS_CKVN = al(WS_ST + (size_t)TT * 2 * 4), WS_END = al(WS_CKVN + (size_t)TT * 256 * 2);
constexpr int LDS_BYTES = 144 * 1024;

struct Params { const float* in[29]; float* out; unsigned char* ws; int ph_lo, ph_hi; };

__device__ __forceinline__ float bf2f(bf16_t b) { return __uint_as_float(((unsigned)b) << 16); }
typedef __bf16 bf16x2_t __attribute__((ext_vector_type(2)));
__device__ __forceinline__ unsigned pk2(float lo, float hi) { f32x2 v = {lo, hi}; bf16x2_t b = __builtin_convertvector(v, bf16x2_t); return __builtin_bit_cast(unsigned, b); }
__device__ __forceinline__ bf16_t f2bf(float f) { return (bf16_t)(pk2(f, 0.f) & 0xffffu); }
__device__ __forceinline__ float lo16(unsigned u) { return __uint_as_float(u << 16); }
__device__ __forceinline__ float hi16(unsigned u) { return __uint_as_float(u & 0xffff0000u); }
__device__ __forceinline__ int opaque_tid() { int t = threadIdx.x; asm volatile("" : "+v"(t)); return t; }
template <int CTRL> __device__ __forceinline__ float dpp_f(float v) { return __int_as_float(__builtin_amdgcn_update_dpp(0, __float_as_int(v), CTRL, 0xF, 0xF, true)); }
__device__ __forceinline__ float row16_sum(float v) { v += dpp_f<0xB1>(v); v += dpp_f<0x4E>(v); v += dpp_f<0x141>(v); v += dpp_f<0x140>(v); return v; }
__device__ __forceinline__ float rl_f(float v, int lane) { return __int_as_float(__builtin_amdgcn_readlane(__float_as_int(v), lane)); }
__device__ __forceinline__ float wave_sum(float v) { v = row16_sum(v); return (rl_f(v, 0) + rl_f(v, 16)) + (rl_f(v, 32) + rl_f(v, 48)); }
__device__ __forceinline__ float xr16_max(float x) { const auto r = __builtin_amdgcn_permlane16_swap(__float_as_uint(x), __float_as_uint(x), false, false); return fmaxf(__uint_as_float(r[0]), __uint_as_float(r[1])); }
__device__ __forceinline__ float xr32_max(float x) { const auto r = __builtin_amdgcn_permlane32_swap(__float_as_uint(x), __float_as_uint(x), false, false); return fmaxf(__uint_as_float(r[0]), __uint_as_float(r[1])); }
__device__ __forceinline__ float xr16_sum(float x) { const auto r = __builtin_amdgcn_permlane16_swap(__float_as_uint(x), __float_as_uint(x), false, false); return __uint_as_float(r[0]) + __uint_as_float(r[1]); }
__device__ __forceinline__ float xr32_sum(float x) { const auto r = __builtin_amdgcn_permlane32_swap(__float_as_uint(x), __float_as_uint(x), false, false); return __uint_as_float(r[0]) + __uint_as_float(r[1]); }
__device__ __forceinline__ float sigmoidf_(float x) { return __builtin_amdgcn_rcpf(1.0f + __builtin_amdgcn_exp2f(-1.4426950408889634f * x)); }
__device__ __forceinline__ float gelu_exact(float v) {
    const float av = fabsf(v), t = __builtin_amdgcn_rcpf(av * 0.2316418882f + 1.0f);
    float q = t * 0.5307027145f + (-0.7265760135f); q = q * t + 0.7107068705f; q = q * t + (-0.142248368f); q = q * t + 0.127414796f; q = q * t;
    const float e = __builtin_amdgcn_exp2f((v * v) * (-0.72134752044f));
    const float m = v * (q * e); return v < 0.f ? m : v - m;
}
__device__ __forceinline__ f32x4 mfma16(bf16x8 a, bf16x8 b, f32x4 c) { return __builtin_amdgcn_mfma_f32_16x16x32_bf16(a, b, c, 0, 0, 0); }

namespace pg8 {
constexpr int BM = 256, BK = 64, HALF = 128, HTB = HALF * BK * 2, STAGE_BYTES = 8 * HTB, NXCD = 8, WGM = 8;
__host__ __device__ __forceinline__ int lds_byte(int r, int c) { const int st = (r >> 4) * 2 + (c >> 5), rr = r & 15, cc = c & 31, ob = rr * 64 + cc * 2; return st * 1024 + (ob ^ (((ob >> 9) & 1) << 5)); }
__host__ __device__ __forceinline__ void stage_rc(int b, int& R, int& C) { const int st = b / 1024, sb = b % 1024, swz = sb ^ (((sb >> 9) & 1) << 5); R = (st >> 1) * 16 + swz / 64; C = (st & 1) * 32 + (swz % 64) / 2; }
__host__ __device__ __forceinline__ int perm32(int rho) { const int n = rho >> 4, i = rho & 15; return 8 * (i >> 2) + 4 * n + (i & 3); }
struct Unit { int pm, pn, g; long ao, bo; };
struct Gemm { const bf16_t* A; const bf16_t* Bt; int M, N, K, lda, ldb; };
struct StaticOrder {
    int nM, nN, nwg, G, c;
    __device__ void init(int M, int N, int G_, int c_) { nM = M / BM; nN = N / BM; nwg = nM * nN; G = G_; c = c_; }
    __device__ bool next(int i, Unit& u) const {
        const long L = (long)i * G + c; if (L >= nwg) return false;
        int wgid = (int)L; { const int q = nwg / NXCD, r = nwg % NXCD, xcd = wgid % NXCD, off = wgid / NXCD; wgid = (xcd < r ? xcd * (q + 1) : r * (q + 1) + (xcd - r) * q) + off; }
        const int nig = WGM * nN, gid = wgid / nig, fm = gid * WGM, gsz = (nM - fm) < WGM ? (nM - fm) : WGM;
        u.pm = fm + ((wgid % nig) % gsz); u.pn = (wgid % nig) / gsz; u.g = 0; u.ao = 0; u.bo = 0; return true;
    }
};

template <class Epi, class Order>
__device__ __forceinline__ void gemm_phase(LAS unsigned char* lds, const Gemm g, const Order& S, const Epi& E) {
    const int tid = opaque_tid(), wid = __builtin_amdgcn_readfirstlane(tid >> 6), lane = tid & 63, wr = wid >> 2, wc = wid & 3, fr = lane & 15, fq = lane >> 4;
    const int K = g.K, nt = K / BK;
    unsigned voffA[2], voffB[2];
#pragma unroll
    for (int i = 0; i < 2; ++i) { int R, C; stage_rc(tid * 16 + i * 8192, R, C); const int Rb = Epi::PERM ? ((R & ~31) + perm32(R & 31)) : R;
        voffA[i] = (unsigned)(R * g.lda + C) * 2u; voffB[i] = (unsigned)(Rb * g.ldb + C) * 2u; }
    const size_t kstep = (size_t)(BK * 2);
    const size_t hstepA = (size_t)HALF * g.lda * 2, hstepB = (size_t)HALF * g.ldb * 2;
    const size_t tstepA = 2 * hstepA, tstepB = 2 * hstepB;
    const unsigned ldsw = (unsigned)wid * 1024u;
    const int aoff = lds_byte(wr * 64 + fr, fq * 8), boff = lds_byte(wc * 32 + fr, fq * 8);
#define PG8_SA(b, h) (((b) * 2 + (h)) * HTB)
#define PG8_SB(b, h) ((4 + (b) * 2 + (h)) * HTB)
#define PG8_STAGE(bufoff, gbase, voff) do { _Pragma("unroll") for (int _i = 0; _i < 2; ++_i) \
        __builtin_amdgcn_global_load_lds((const unsigned*)((const char*)(gbase) + (voff)[_i]), (LAS unsigned*)(lds + (bufoff) + ldsw + _i * 8192), 16, 0, 0); } while (0)
#define PG8_LDA(dst, b, h) do { _Pragma("unroll") for (int m = 0; m < 4; ++m) _Pragma("unroll") for (int k = 0; k < 2; ++k) dst[m][k] = *(const LAS bf16x8*)(lds + PG8_SA(b, h) + aoff + m * 2048 + k * 1024); } while (0)
#define PG8_LDB(dst, b, h) do { _Pragma("unroll") for (int n = 0; n < 2; ++n) _Pragma("unroll") for (int k = 0; k < 2; ++k) dst[n][k] = *(const LAS bf16x8*)(lds + PG8_SB(b, h) + boff + n * 2048 + k * 1024); } while (0)
#define PG8_MMA(ai, bj, At, Bt) do { __builtin_amdgcn_s_setprio(1); _Pragma("unroll") for (int m = 0; m < 4; ++m) _Pragma("unroll") for (int n = 0; n < 2; ++n) _Pragma("unroll") for (int k = 0; k < 2; ++k) \
        acc[ai][bj][m][n] = __builtin_amdgcn_mfma_f32_16x16x32_bf16(Bt[n][k], At[m][k], acc[ai][bj][m][n], 0, 0, 0); __builtin_amdgcn_s_setprio(0); } while (0)
#define PG8_WAIT_V(n) asm volatile("s_waitcnt vmcnt(" #n ")" ::: "memory")
#define PG8_WAIT_L(n) asm volatile("s_waitcnt lgkmcnt(" #n ")" ::: "memory")
#define PG8_BAR __builtin_amdgcn_s_barrier()
#define PG8_SCHED __builtin_amdgcn_sched_barrier(0)
    Unit cur, nxt; int ui = 0;
    if (!S.next(0, cur)) return;
    f32x4 acc[2][2][4][2];
#pragma unroll
    for (int a = 0; a < 2; ++a)
#pragma unroll
        for (int b = 0; b < 2; ++b)
#pragma unroll
            for (int m = 0; m < 4; ++m)
#pragma unroll
                for (int n = 0; n < 2; ++n) acc[a][b][m][n] = (f32x4){0.f, 0.f, 0.f, 0.f};
    bf16x8 At[4][2], B0[2][2], B1[2][2];
    const char* cA = (const char*)g.A + (size_t)cur.pm * tstepA + cur.ao; const char* cB = (const char*)g.Bt + (size_t)cur.pn * tstepB + cur.bo;
    PG8_STAGE(PG8_SB(0, 0), cB, voffB); PG8_STAGE(PG8_SA(0, 0), cA, voffA); PG8_STAGE(PG8_SB(0, 1), cB + hstepB, voffB); PG8_STAGE(PG8_SA(0, 1), cA + hstepA, voffA);
    if (wr == 1) PG8_BAR;
    PG8_WAIT_V(4); PG8_BAR;
    PG8_STAGE(PG8_SB(1, 0), cB + kstep, voffB); PG8_STAGE(PG8_SA(1, 0), cA + kstep, voffA); PG8_STAGE(PG8_SB(1, 1), cB + hstepB + kstep, voffB);
    PG8_WAIT_V(6); PG8_BAR;
    for (;;) {
        const bool has_next = S.next(ui + 1, nxt);
        const char* nA = has_next ? (const char*)g.A + (size_t)nxt.pm * tstepA + nxt.ao : cA; const char* nB = has_next ? (const char*)g.Bt + (size_t)nxt.pn * tstepB + nxt.bo : cB;
        for (int t = 0; t < nt; t += 2) {
            const bool last = (t == nt - 2);
            const char* a1 = cA + (size_t)(t + 1) * kstep;
            const char* a2 = last ? nA : cA + (size_t)(t + 2) * kstep; const char* b2 = last ? nB : cB + (size_t)(t + 2) * kstep;
            const char* a3 = a2 + kstep; const char* b3 = b2 + kstep;
            if constexpr (Epi::HOOK) { if (t == 8 || t == 16) E.mid(acc, cur, t, wr, wc, fr, fq); }
            PG8_LDB(B0, 0, 0); PG8_SCHED; PG8_LDA(At, 0, 0); PG8_STAGE(PG8_SA(1, 1), a1 + hstepA, voffA);
            PG8_WAIT_L(8); PG8_BAR; PG8_WAIT_L(0); PG8_MMA(0, 0, At, B0); PG8_BAR; PG8_SCHED;
            PG8_LDB(B1, 0, 1); PG8_STAGE(PG8_SB(0, 0), b2, voffB);
            PG8_BAR; PG8_WAIT_L(0); PG8_MMA(0, 1, At, B1); PG8_BAR;
            PG8_LDA(At, 0, 1); PG8_STAGE(PG8_SA(0, 0), a2, voffA);
            PG8_BAR; PG8_WAIT_L(0); PG8_MMA(1, 0, At, B0); PG8_BAR; PG8_SCHED;
            PG8_STAGE(PG8_SB(0, 1), b2 + hstepB, voffB);
            PG8_WAIT_V(6); PG8_BAR; PG8_MMA(1, 1, At, B1); PG8_BAR;
            PG8_LDB(B0, 1, 0); PG8_SCHED; PG8_LDA(At, 1, 0); PG8_STAGE(PG8_SA(0, 1), a2 + hstepA, voffA);
            PG8_WAIT_L(8); PG8_BAR; PG8_WAIT_L(0); PG8_MMA(0, 0, At, B0); PG8_BAR; PG8_SCHED;
            PG8_LDB(B1, 1, 1); PG8_STAGE(PG8_SB(1, 0), b3, voffB);
            PG8_BAR; PG8_WAIT_L(0); PG8_MMA(0, 1, At, B1); PG8_BAR;
            PG8_LDA(At, 1, 1); PG8_STAGE(PG8_SA(1, 0), a3, voffA);
            PG8_BAR; PG8_WAIT_L(0); PG8_MMA(1, 0, At, B0); PG8_BAR; PG8_SCHED;
            PG8_STAGE(PG8_SB(1, 1), b3 + hstepB, voffB);
            PG8_WAIT_V(6); PG8_BAR; PG8_MMA(1, 1, At, B1); PG8_BAR;
        }
        E(acc, cur, wr, wc, fr, fq);
        if (!has_next) break;
#pragma unroll
        for (int a = 0; a < 2; ++a)
#pragma unroll
            for (int b = 0; b < 2; ++b)
#pragma unroll
                for (int m = 0; m < 4; ++m)
#pragma unroll
                    for (int n = 0; n < 2; ++n) acc[a][b][m][n] = (f32x4){0.f, 0.f, 0.f, 0.f};
        cur = nxt; cA = nA; cB = nB; ++ui;
    }
    PG8_WAIT_V(0);
    if (wr == 0) PG8_BAR;
    PG8_BAR;
#undef PG8_SA
#undef PG8_SB
#undef PG8_STAGE
#undef PG8_LDA
#undef PG8_LDB
#undef PG8_MMA
#undef PG8_WAIT_V
#undef PG8_WAIT_L
#undef PG8_BAR
#undef PG8_SCHED
}
}
using pg8::Unit;

#define EPI_LOOP_ROWS _Pragma("unroll") for (int ai = 0; ai < 2; ++ai) _Pragma("unroll") for (int m = 0; m < 4; ++m)
__device__ __forceinline__ uint4 pack8(f32x4 a, f32x4 b) { uint4 o; o.x = pk2(a[0], a[1]); o.y = pk2(a[2], a[3]); o.z = pk2(b[0], b[1]); o.w = pk2(b[2], b[3]); return o; }

struct EpiZ {
    static constexpr bool PERM = true, HOOK = false;
    bf16_t* Z;
    __device__ __forceinline__ void operator()(const f32x4 (&acc)[2][2][4][2], const Unit& u, int wr, int wc, int fr_, int fq_) const {
        int fr = fr_, fq = fq_; asm volatile("" : "+v"(fr), "+v"(fq));
        const int mode = (u.pn >= 14 && u.pn < 26) ? 2 : ((u.pn >= 10 && u.pn < 14) ? 1 : 0);
        const int row0 = u.pm * 256 + wr * 64 + fr, col0 = u.pn * 256 + wc * 32 + 8 * fq;
        EPI_LOOP_ROWS { bf16_t* rp = Z + (size_t)(row0 + ai * 128 + m * 16) * NZ + col0;
#pragma unroll
            for (int bj = 0; bj < 2; ++bj) { f32x4 v0 = acc[ai][bj][m][0], v1 = acc[ai][bj][m][1];
                if (mode == 1) { _Pragma("unroll") for (int j = 0; j < 4; ++j) { v0[j] = gelu_exact(v0[j]); v1[j] = gelu_exact(v1[j]); } }
                else if (mode == 2) { _Pragma("unroll") for (int j = 0; j < 4; ++j) { v0[j] = sigmoidf_(v0[j]); v1[j] = sigmoidf_(v1[j]); } }
                *(uint4*)(rp + bj * 128) = pack8(v0, v1); } }
    }
};
struct EpiQ {
    static constexpr bool PERM = false, HOOK = false;
    bf16_t* Q; const float* rope;
    __device__ __forceinline__ void operator()(const f32x4 (&acc)[2][2][4][2], const Unit& u, int wr, int wc, int fr_, int fq_) const {
        int fr = fr_, fq = fq_; asm volatile("" : "+v"(fr), "+v"(fq));
        const int row0 = u.pm * 256 + wr * 64 + fr;
        const bool rp0 = (((u.pn * 256 + wc * 32) >> 5) % 3) == 2, rp1 = (((u.pn * 256 + 128 + wc * 32) >> 5) % 3) == 2, anyr = rp0 || rp1;
        f32x4 c0n = {1.f, 0.f, 1.f, 0.f}, c1n = c0n;
#define EQ_PIDX(row_) ((row_) < TP ? ((row_) & (SEQ - 1)) : (SEQ + (((row_) - TP) & (DSEQ - 1))))
        if (anyr) { const float* rp = rope + ((size_t)EQ_PIDX(row0) * 16 + 4 * fq) * 2; c0n = *(const f32x4*)rp; c1n = *(const f32x4*)(rp + 4); }
#pragma unroll
        for (int s8 = 0; s8 < 8; ++s8) { const int ai = s8 >> 2, m = s8 & 3; const int row = row0 + ai * 128 + m * 16; const f32x4 c0 = c0n, c1 = c1n;
            if (anyr && s8 + 1 < 8) { const int rown = row0 + ((s8 + 1) >> 2) * 128 + ((s8 + 1) & 3) * 16; const float* rp = rope + ((size_t)EQ_PIDX(rown) * 16 + 4 * fq) * 2; c0n = *(const f32x4*)rp; c1n = *(const f32x4*)(rp + 4); }
            const float cs[4] = {c0[0], c0[2], c1[0], c1[2]}, sn[4] = {c0[1], c0[3], c1[1], c1[3]};
#pragma unroll
            for (int bj = 0; bj < 2; ++bj) { const int cb = u.pn * 256 + bj * 128 + wc * 32; f32x4 v0 = acc[ai][bj][m][0] * QSCALE, v1 = acc[ai][bj][m][1] * QSCALE;
                if (bj ? rp1 : rp0) { _Pragma("unroll") for (int j = 0; j < 4; ++j) { const float a = v0[j], b = v1[j]; v0[j] = a * cs[j] - b * sn[j]; v1[j] = b * cs[j] + a * sn[j]; } }
                bf16_t* dp = Q + (size_t)row * 768 + cb + 4 * fq;
                *(uint2*)dp = make_uint2(pk2(v0[0], v0[1]), pk2(v0[2], v0[3])); *(uint2*)(dp + 16) = make_uint2(pk2(v1[0], v1[1]), pk2(v1[2], v1[3])); }
            __builtin_amdgcn_sched_barrier(0); }
#undef EQ_PIDX
    }
};
struct EpiKN {
    static constexpr bool PERM = true, HOOK = false;
    bf16_t* KN; bf16_t* KNS; int mode;
    __device__ __forceinline__ void operator()(const f32x4 (&acc)[2][2][4][2], const Unit& u, int wr, int wc, int fr_, int fq_) const {
        int fr = fr_, fq = fq_; asm volatile("" : "+v"(fr), "+v"(fq));
        const int row0 = u.pm * 256 + wr * 64 + fr, col0 = u.pn * 256 + wc * 32 + 8 * fq;
        EPI_LOOP_ROWS { const int row = row0 + ai * 128 + m * 16; bf16_t* rp;
            if (mode == 1) rp = KNS + ((size_t)(row >> 12) * KSS + (row & 4095)) * 512;
            else if (row < TP) rp = KN + (size_t)row * 512;
            else { const int s = row - TP; rp = KNS + ((size_t)(s >> 5) * KSS + PAST + (s & 31)) * 512; }
#pragma unroll
            for (int bj = 0; bj < 2; ++bj) *(uint4*)(rp + col0 + bj * 128) = pack8(acc[ai][bj][m][0], acc[ai][bj][m][1]); }
    }
};
struct EpiVT {
    static constexpr bool PERM = true, HOOK = false;
    bf16_t* VT; bf16_t* VTS; int mode;
    __device__ __forceinline__ void operator()(const f32x4 (&acc)[2][2][4][2], const Unit& u, int wr, int wc, int fr_, int fq_) const {
        int fr = fr_, fq = fq_; asm volatile("" : "+v"(fr), "+v"(fq));
        const int row0 = u.pm * 256 + wr * 64 + fr, col0 = u.pn * 256 + wc * 32 + 8 * fq;
        EPI_LOOP_ROWS { const int row = row0 + ai * 128 + m * 16;
#pragma unroll
            for (int bj = 0; bj < 2; ++bj) { const int col = col0 + bj * 128; bf16_t* dp;
                if (mode == 1) dp = VTS + ((size_t)(col >> 12) * 512 + row) * KSS + (col & 4095);
                else if (col < TP) dp = VT + ((size_t)(col >> 11) * 512 + row) * SEQ + (col & (SEQ - 1));
                else { const int s = col - TP; dp = VTS + ((size_t)(s >> 5) * 512 + row) * KSS + PAST + (s & 31); }
                *(uint4*)dp = pack8(acc[ai][bj][m][0], acc[ai][bj][m][1]); } }
    }
};
struct EpiMerge {
    static constexpr bool PERM = true, HOOK = true;
    bf16_t* Mo; const bf16_t* Z;
    __device__ __forceinline__ void mid(f32x4 (&acc)[2][2][4][2], const Unit& u, int t, int wr, int wc, int fr_, int fq_) const {
        int fr = fr_, fq = fq_; asm volatile("" : "+v"(fr), "+v"(fq));
        const int row0 = u.pm * 256 + wr * 64 + fr, col0 = u.pn * 256 + wc * 32 + 8 * fq; const int gp = (t == 8) ? ZGA : ZGB;
        const bf16_t* base = Z + (size_t)row0 * NZ + col0 + gp;
#define MG_OFF(s_) ((size_t)((((s_) >> 3) & 1) * 128 + (((s_) >> 1) & 3) * 16) * NZ + ((s_) & 1) * 128)
        uint4 pn = *(const uint4*)(base + MG_OFF(0)), qn = *(const uint4*)(base + MG_OFF(0) + 1024);
#pragma unroll
        for (int st = 0; st < 16; ++st) { const int ai = st >> 3, m = (st >> 1) & 3, bj = st & 1; const uint4 p = pn, q = qn;
            if (st + 1 < 16) { pn = *(const uint4*)(base + MG_OFF(st + 1)); qn = *(const uint4*)(base + MG_OFF(st + 1) + 1024); }
            const unsigned pu[4] = {p.x, p.y, p.z, p.w}, qu[4] = {q.x, q.y, q.z, q.w};
#pragma unroll
            for (int n = 0; n < 2; ++n)
#pragma unroll
                for (int j = 0; j < 4; ++j) { const unsigned a_ = pu[n * 2 + (j >> 1)], b_ = qu[n * 2 + (j >> 1)];
                    const float sp = (j & 1) ? hi16(a_) : lo16(a_), sq = (j & 1) ? hi16(b_) : lo16(b_);
                    acc[ai][bj][m][n][j] *= sp * __builtin_amdgcn_rcpf(fmaxf(sq, 1e-30f)); }
            __builtin_amdgcn_sched_barrier(0); }
#undef MG_OFF
    }
    __device__ __forceinline__ void operator()(const f32x4 (&acc)[2][2][4][2], const Unit& u, int wr, int wc, int fr_, int fq_) const {
        int fr = fr_, fq = fq_; asm volatile("" : "+v"(fr), "+v"(fq));
        const int row0 = u.pm * 256 + wr * 64 + fr, col0 = u.pn * 256 + wc * 32 + 8 * fq;
        const bf16_t* base = Z + (size_t)row0 * NZ + ZGC + col0;
#define MG_OFF(s_) ((size_t)((((s_) >> 3) & 1) * 128 + (((s_) >> 1) & 3) * 16) * NZ + ((s_) & 1) * 128)
        uint4 pn = *(const uint4*)(base + MG_OFF(0));
#pragma unroll
        for (int st = 0; st < 16; ++st) { const int ai = st >> 3, m = (st >> 1) & 3, bj = st & 1; const uint4 p = pn; const int row = row0 + ai * 128 + m * 16;
            if (st + 1 < 16) pn = *(const uint4*)(base + MG_OFF(st + 1));
            const unsigned pu[4] = {p.x, p.y, p.z, p.w};
            f32x4 v0 = acc[ai][bj][m][0], v1 = acc[ai][bj][m][1];
            v0[0] *= lo16(pu[0]); v0[1] *= hi16(pu[0]); v0[2] *= lo16(pu[1]); v0[3] *= hi16(pu[1]);
            v1[0] *= lo16(pu[2]); v1[1] *= hi16(pu[2]); v1[2] *= lo16(pu[3]); v1[3] *= hi16(pu[3]);
            *(uint4*)(Mo + (size_t)row * 1024 + col0 + bj * 128) = pack8(v0, v1); }
#undef MG_OFF
    }
};
struct EpiRes {
    static constexpr bool PERM = false, HOOK = false;
    float* X; const float* ST; const float* G; const float* B;
    __device__ __forceinline__ void operator()(const f32x4 (&acc)[2][2][4][2], const Unit& u, int wr, int wc, int fr_, int fq_) const {
        int fr = fr_, fq = fq_; asm volatile("" : "+v"(fr), "+v"(fq));
        const int row0 = u.pm * 256 + wr * 64 + fr, col0 = u.pn * 256 + wc * 32 + 4 * fq;
        f32x4 gv[2][2], bv[2][2];
        if (ST) {
#pragma unroll
            for (int bj = 0; bj < 2; ++bj)
#pragma unroll
                for (int n = 0; n < 2; ++n) { gv[bj][n] = *(const f32x4*)(G + col0 + bj * 128 + n * 16); bv[bj][n] = *(const f32x4*)(B + col0 + bj * 128 + n * 16); } }
        f32x4 xn[2][2]; f32x2 stn = {0.f, 1.f};
        {   const float* rp0 = X + (size_t)row0 * 1024 + col0;
#pragma unroll
            for (int bj = 0; bj < 2; ++bj)
#pragma unroll
                for (int n = 0; n < 2; ++n) xn[bj][n] = *(const f32x4*)(rp0 + bj * 128 + n * 16);
            if (ST) stn = *(const f32x2*)(ST + (size_t)row0 * 2); }
#pragma unroll
        for (int s = 0; s < 8; ++s) { const int ai = s >> 2, m = s & 3; const int row = row0 + ai * 128 + m * 16; float* rp = X + (size_t)row * 1024 + col0;
            f32x4 xc[2][2]; const f32x2 st = stn;
#pragma unroll
            for (int bj = 0; bj < 2; ++bj)
#pragma unroll
                for (int n = 0; n < 2; ++n) xc[bj][n] = xn[bj][n];
            if (s + 1 < 8) { const int rown = row0 + ((s + 1) >> 2) * 128 + ((s + 1) & 3) * 16; const float* rpn = X + (size_t)rown * 1024 + col0;
#pragma unroll
                for (int bj = 0; bj < 2; ++bj)
#pragma unroll
                    for (int n = 0; n < 2; ++n) xn[bj][n] = *(const f32x4*)(rpn + bj * 128 + n * 16);
                if (ST) stn = *(const f32x2*)(ST + (size_t)rown * 2); }
#pragma unroll
            for (int bj = 0; bj < 2; ++bj)
#pragma unroll
                for (int n = 0; n < 2; ++n) { f32x4 x = xc[bj][n]; if (ST) x = (x - st[0]) * st[1] * gv[bj][n] + bv[bj][n]; *(f32x4*)(rp + bj * 128 + n * 16) = x * ALPHA + acc[ai][bj][m][n]; }
            __builtin_amdgcn_sched_barrier(0); }
    }
};
struct EpiUp {
    static constexpr bool PERM = true, HOOK = false;
    bf16_t* H;
    __device__ __forceinline__ void operator()(const f32x4 (&acc)[2][2][4][2], const Unit& u, int wr, int wc, int fr_, int fq_) const {
        int fr = fr_, fq = fq_; asm volatile("" : "+v"(fr), "+v"(fq));
        const int row0 = u.pm * 256 + wr * 64 + fr, col0 = u.pn * 128 + wc * 32 + 8 * fq;
        EPI_LOOP_ROWS { f32x4 v0, v1;
#pragma unroll
            for (int j = 0; j < 4; ++j) { const float g0 = acc[ai][0][m][0][j], g1 = acc[ai][0][m][1][j];
                v0[j] = g0 * sigmoidf_(g0) * acc[ai][1][m][0][j]; v1[j] = g1 * sigmoidf_(g1) * acc[ai][1][m][1][j]; }
            *(uint4*)(H + (size_t)(row0 + ai * 128 + m * 16) * DFF + col0) = pack8(v0, v1); }
    }
};


struct EpiKV4 {
    static constexpr bool PERM = true, HOOK = false;
    EpiKN kn0, kn1; EpiVT vt0, vt1;
    __device__ __forceinline__ void operator()(const f32x4 (&acc)[2][2][4][2], const Unit& u, int wr, int wc, int fr, int fq) const {
        if (u.g == 0) kn0(acc, u, wr, wc, fr, fq); else if (u.g == 1) vt0(acc, u, wr, wc, fr, fq); else if (u.g == 2) kn1(acc, u, wr, wc, fr, fq); else vt1(acc, u, wr, wc, fr, fq);
    }
};
struct KV4Order {
    int G, c; long oW, oWv, oC, oX;
    __device__ bool next(int i, Unit& u) const {
        int L;
        if (G != 256) { L = i * G + c; if (L >= 772) return false; }
        else if (i < 3) L = i * 256 + c;
        else { const int e = c - 195; if (i > 3 || e < 0 || e >= 4) return false; L = 768 + e; }
        int g, idx;
        if (L < 130) { g = 0; idx = L; } else if (L < 260) { g = 1; idx = L - 130; } else if (L < 516) { g = 2; idx = L - 260; } else { g = 3; idx = L - 516; }
        u.g = g;
        if (g == 0 || g == 2) { u.pm = idx >> 1; u.pn = idx & 1; } else { const int nn = (g == 1) ? 65 : 128; u.pm = idx / nn; u.pn = idx - u.pm * nn; }
        u.ao = oC + (long)(g & 1) * (oWv - oC) + (long)(g == 2) * (oX - oC); u.bo = oW + (long)(g == 1) * (oC - oW) + (long)(g == 3) * (oX - oW); return true;
    }
};

template <class Epi>
__device__ __forceinline__ void run_gemm(unsigned char* smem, const bf16_t* A, int lda, const bf16_t* Bt, int ldb, int M, int N, int K, int rot, const Epi& E) {
    int Kop = K; asm volatile("" : "+s"(Kop));
    pg8::Gemm g; g.A = A; g.Bt = Bt; g.M = M; g.N = N; g.K = Kop; g.lda = lda; g.ldb = ldb;
    pg8::StaticOrder S; S.init(M, N, (int)gridDim.x, (int)((blockIdx.x + gridDim.x - (rot % gridDim.x)) % gridDim.x));
    pg8::gemm_phase<Epi, pg8::StaticOrder>((LAS unsigned char*)smem, g, S, E);
    __syncthreads();
}


template <int NSEG, int MODE>
__device__ __forceinline__ void skinny_gemm(unsigned char* smem, const Params& p, const bf16_t* A, int lda, const bf16_t* Bt, int ldb, int Kseg, const float* ST = nullptr, const float* Gp = nullptr, const float* Bp = nullptr) {
    const int tid = opaque_tid(), lane = tid & 63, w = tid >> 6, fr = lane & 15, fq = lane >> 4;
    float* part = (float*)smem;
    for (int tile = blockIdx.x; tile < 256; tile += gridDim.x) {
        const int rt = tile >> 5, ct = tile & 31;
        const bf16_t* ap = A + (size_t)(TP + 32 * rt + fr) * lda + fq * 8;
        const bf16_t* bp = Bt + (size_t)(32 * ct + fr) * ldb + fq * 8;
#pragma unroll
        for (int seg = 0; seg < NSEG; ++seg) {
            f32x4 acc[2][2];
#pragma unroll
            for (int i = 0; i < 2; ++i) { acc[i][0] = (f32x4){0.f, 0.f, 0.f, 0.f}; acc[i][1] = (f32x4){0.f, 0.f, 0.f, 0.f}; }
#pragma unroll 4
            for (int st = w; st < (Kseg >> 5); st += 8) { const int k0 = seg * Kseg + st * 32;
                const bf16x8 a0 = *(const bf16x8*)(ap + k0), a1 = *(const bf16x8*)(ap + (size_t)16 * lda + k0);
                const bf16x8 b0 = *(const bf16x8*)(bp + k0), b1 = *(const bf16x8*)(bp + (size_t)16 * ldb + k0);
                acc[0][0] = mfma16(b0, a0, acc[0][0]); acc[0][1] = mfma16(b1, a0, acc[0][1]); acc[1][0] = mfma16(b0, a1, acc[1][0]); acc[1][1] = mfma16(b1, a1, acc[1][1]); }
#pragma unroll
            for (int mt = 0; mt < 2; ++mt)
#pragma unroll
                for (int nt = 0; nt < 2; ++nt) *(f32x4*)(part + ((size_t)((seg * 8 + w) * 32 + mt * 16 + fr)) * 32 + nt * 16 + 4 * fq) = acc[mt][nt];
        }
        __syncthreads();
        {   const int row = tid >> 4, c0 = (tid & 15) * 2; const int rg = TP + 32 * rt + row, cg_ = 32 * ct + c0;
            float v[NSEG][2];
#pragma unroll
            for (int seg = 0; seg < NSEG; ++seg) { v[seg][0] = 0.f; v[seg][1] = 0.f;
#pragma unroll
                for (int ww = 0; ww < 8; ++ww) { const f32x2 t = *(const f32x2*)(part + ((size_t)((seg * 8 + ww) * 32 + row)) * 32 + c0); v[seg][0] += t[0]; v[seg][1] += t[1]; } }
            if (MODE == 0) { f32x2* xp = (f32x2*)(p.out + O_YP + (size_t)rg * 1024 + cg_); f32x2 x = *xp;
                if (ST) { const f32x2 st = *(const f32x2*)(ST + (size_t)rg * 2); const f32x2 g2 = *(const f32x2*)(Gp + cg_), b2 = *(const f32x2*)(Bp + cg_); x = (x - st[0]) * st[1] * g2 + b2; }
                x[0] = x[0] * ALPHA + v[0][0]; x[1] = x[1] * ALPHA + v[0][1]; *xp = x; }
            else { const bf16_t* Z = (const bf16_t*)(p.ws + WS_Z); float o0 = 0.f, o1 = 0.f;
#pragma unroll
                for (int seg = 0; seg < NSEG; ++seg) { const unsigned gte = *(const unsigned*)(Z + (size_t)rg * NZ + ZGA + 1024 * seg + cg_); o0 += lo16(gte) * v[seg][0]; o1 += hi16(gte) * v[seg][1]; }
                *(unsigned*)((bf16_t*)(p.ws + WS_XB) + (size_t)rg * 1024 + cg_) = pk2(o0, o1); }
        }
        __syncthreads();
    }
}

__device__ __forceinline__ int srccol(int map, int n) {
    if (map == 0) return n;
    if (map == 1) { if (n < 512) return n; if (n < ZKR) return n + 32; if (n < ZKR + 32) return n - ZKR + 512; return -1; }
    const int u = n >> 8, bj = (n >> 7) & 1, j = n & 127; return bj * DFF + u * 128 + j;
}
__device__ __forceinline__ void conv_w(unsigned char* smem, const float* src, int ldsrc, int K, bf16_t* dst, int ldd, int koff, int Ndst, int map, int& base) {
    const int tid = opaque_tid(), G = gridDim.x, nk = K >> 6, ntl = (Ndst >> 6) * nk;
    bf16_t* T = (bf16_t*)smem;
    const int first = ((int)blockIdx.x - (base % G) + G) % G;
    const int c4 = (tid & 15) * 4, r = tid >> 4;
    f32x4 v0 = {0.f, 0.f, 0.f, 0.f}, v1 = {0.f, 0.f, 0.f, 0.f};
#define CONV_LOAD(tile_) do { const int tn_ = (tile_) / nk, tk_ = (tile_) - tn_ * nk; const int sc_ = srccol(map, tn_ * 64 + c4); v0 = (f32x4){0.f, 0.f, 0.f, 0.f}; v1 = v0; \
        if (sc_ >= 0) { v0 = __builtin_nontemporal_load((const f32x4*)(src + (size_t)(tk_ * 64 + r) * ldsrc + sc_)); v1 = __builtin_nontemporal_load((const f32x4*)(src + (size_t)(tk_ * 64 + r + 32) * ldsrc + sc_)); } } while (0)
    f32x4 w0 = {0.f, 0.f, 0.f, 0.f}, w1 = w0;
    if (first + G < ntl) { CONV_LOAD(first + G); w0 = v0; w1 = v1; }
    if (first < ntl) CONV_LOAD(first);
    for (int tile = first; tile < ntl; tile += G) {
        const int tn = tile / nk, tk = tile - tn * nk, n0 = tn * 64, k0 = tk * 64;
        const f32x4 a0 = v0, a1 = v1;
        v0 = w0; v1 = w1;
        if (tile + 2 * G < ntl) { const f32x4 s0_ = v0, s1_ = v1; CONV_LOAD(tile + 2 * G); w0 = v0; w1 = v1; v0 = s0_; v1 = s1_; }
        T[(c4 + 0) * 72 + r] = f2bf(a0[0]); T[(c4 + 1) * 72 + r] = f2bf(a0[1]); T[(c4 + 2) * 72 + r] = f2bf(a0[2]); T[(c4 + 3) * 72 + r] = f2bf(a0[3]);
        T[(c4 + 0) * 72 + r + 32] = f2bf(a1[0]); T[(c4 + 1) * 72 + r + 32] = f2bf(a1[1]); T[(c4 + 2) * 72 + r + 32] = f2bf(a1[2]); T[(c4 + 3) * 72 + r + 32] = f2bf(a1[3]);
        __syncthreads();
        const int row = tid >> 3, seg = tid & 7;
        *(uint4*)(dst + (size_t)(n0 + row) * ldd + koff + k0 + seg * 8) = *(const uint4*)(T + row * 72 + seg * 8);
        __syncthreads();
    }
#undef CONV_LOAD
    base += ntl;
}
__device__ __forceinline__ void conv_layer(unsigned char* smem, const Params& p, int l) {
    bf16_t* W = (bf16_t*)(p.ws + WS_WT); int base = 0;
    conv_w(smem, p.in[7] + (size_t)l * 1024 * 6688, 6688, 1024, W + W_IN, 1024, 0, NZ, 1, base);
    conv_w(smem, p.in[9] + (size_t)l * 256 * 768, 768, 256, W + W_UQ, 256, 0, 768, 0, base);
    conv_w(smem, p.in[10] + (size_t)l * 256 * 512, 512, 256, W + W_UKV, 256, 0, 512, 0, base);
    conv_w(smem, p.in[12] + (size_t)l * 256 * 512, 512, 256, W + W_UKV + 512 * 256, 256, 0, 512, 0, base);
    conv_w(smem, p.in[19] + (size_t)l * 512 * 1024, 1024, 512, W + W_CAT, 1536, 0, 1024, 0, base);
    conv_w(smem, p.in[20] + (size_t)l * 512 * 1024, 1024, 512, W + W_CAT, 1536, 512, 1024, 0, base);
    conv_w(smem, p.in[21] + (size_t)l * 512 * 1024, 1024, 512, W + W_CAT, 1536, 1024, 1024, 0, base);
    conv_w(smem, p.in[22] + (size_t)l * 1024 * 1024, 1024, 1024, W + W_O, 1024, 0, 1024, 0, base);
    conv_w(smem, p.in[25] + (size_t)l * 1024 * 5632, 5632, 1024, W + W_UP, 1024, 0, 5632, 2, base);
    conv_w(smem, p.in[26] + (size_t)l * DFF * 1024, 1024, DFF, W + W_DN, DFF, 0, 1024, 0, base);
}

__device__ __forceinline__ void ln_rows(const float* srcP, const float* srcS, float* X, bf16_t* XB, const float* g, const float* b, float* ST, bool writeX) {
    const int tid_ = opaque_tid(); const int lane = tid_ & 63, gw = blockIdx.x * 8 + (tid_ >> 6), nw = gridDim.x * 8;
    f32x4 gv[4], bv[4];
#pragma unroll
    for (int i = 0; i < 4; ++i) { gv[i] = *(const f32x4*)(g + i * 256 + lane * 4); bv[i] = *(const f32x4*)(b + i * 256 + lane * 4); }
    f32x4 vn[2][4];
#define LN_LOAD(r0_) do { const int ra_ = (r0_), rb_ = ((r0_) + nw < TT) ? (r0_) + nw : (r0_); \
        const float* pa_ = (ra_ < TP) ? srcP + (size_t)ra_ * 1024 : srcS + (size_t)(ra_ - TP) * 1024; const float* pb_ = (rb_ < TP) ? srcP + (size_t)rb_ * 1024 : srcS + (size_t)(rb_ - TP) * 1024; \
        _Pragma("unroll") for (int i = 0; i < 4; ++i) { vn[0][i] = *(const f32x4*)(pa_ + i * 256 + lane * 4); vn[1][i] = *(const f32x4*)(pb_ + i * 256 + lane * 4); } } while (0)
    if (gw < TT) LN_LOAD(gw);
    for (int row0 = gw; row0 < TT; row0 += 2 * nw) {
        const int row1 = row0 + nw; const bool has1 = row1 < TT;
        f32x4 v[2][4]; float s0 = 0.f, s1 = 0.f;
#pragma unroll
        for (int i = 0; i < 4; ++i) { v[0][i] = vn[0][i]; v[1][i] = vn[1][i]; }
        if (row0 + 2 * nw < TT) LN_LOAD(row0 + 2 * nw);
#pragma unroll
        for (int i = 0; i < 4; ++i) { s0 += v[0][i][0] + v[0][i][1] + v[0][i][2] + v[0][i][3]; s1 += v[1][i][0] + v[1][i][1] + v[1][i][2] + v[1][i][3]; }
        s0 = wave_sum(s0); s1 = wave_sum(s1);
        const float mu0 = s0 * (1.0f / 1024.0f), mu1 = s1 * (1.0f / 1024.0f); float q0 = 0.f, q1 = 0.f;
#pragma unroll
        for (int i = 0; i < 4; ++i) { v[0][i] = v[0][i] - mu0; v[1][i] = v[1][i] - mu1;
            q0 += v[0][i][0] * v[0][i][0] + v[0][i][1] * v[0][i][1] + v[0][i][2] * v[0][i][2] + v[0][i][3] * v[0][i][3];
            q1 += v[1][i][0] * v[1][i][0] + v[1][i][1] * v[1][i][1] + v[1][i][2] * v[1][i][2] + v[1][i][3] * v[1][i][3]; }
        q0 = wave_sum(q0); q1 = wave_sum(q1);
        const float rs0 = rsqrtf(q0 * (1.0f / 1024.0f) + EPS), rs1 = rsqrtf(q1 * (1.0f / 1024.0f) + EPS);
        if (ST && lane == 0) { *(f32x2*)(ST + (size_t)row0 * 2) = (f32x2){mu0, rs0}; if (has1) *(f32x2*)(ST + (size_t)row1 * 2) = (f32x2){mu1, rs1}; }
#pragma unroll
        for (int i = 0; i < 4; ++i) { const f32x4 o = v[0][i] * rs0 * gv[i] + bv[i];
            if (writeX) *(f32x4*)(X + (size_t)row0 * 1024 + i * 256 + lane * 4) = o;
            *(uint2*)(XB + (size_t)row0 * 1024 + i * 256 + lane * 4) = make_uint2(pk2(o[0], o[1]), pk2(o[2], o[3])); }
        if (has1) {
#pragma unroll
            for (int i = 0; i < 4; ++i) { const f32x4 o = v[1][i] * rs1 * gv[i] + bv[i];
                if (writeX) *(f32x4*)(X + (size_t)row1 * 1024 + i * 256 + lane * 4) = o;
                *(uint2*)(XB + (size_t)row1 * 1024 + i * 256 + lane * 4) = make_uint2(pk2(o[0], o[1]), pk2(o[2], o[3])); } }
    }
}

__device__ __forceinline__ void rowops(const Params& p, int l) {
    const int tid_ = opaque_tid(); const int lane = tid_ & 63, gw = blockIdx.x * 8 + (tid_ >> 6), nw = gridDim.x * 8;
    bf16_t* Z = (bf16_t*)(p.ws + WS_Z); const float* rope = (const float*)(p.ws + WS_ROPE);
    bf16_t* KRB = (bf16_t*)(p.ws + WS_KRB); bf16_t* KRS = (bf16_t*)(p.ws + WS_KRS);
    const f32x4 gq = *(const f32x4*)(p.in[8] + l * 256 + lane * 4), gk = *(const f32x4*)(p.in[11] + l * 256 + lane * 4);
    const f32x4 lg0 = *(const f32x4*)(p.in[15] + l * 512 + lane * 8), lg1 = *(const f32x4*)(p.in[15] + l * 512 + lane * 8 + 4);
    const f32x4 lb0 = *(const f32x4*)(p.in[16] + l * 512 + lane * 8), lb1 = *(const f32x4*)(p.in[16] + l * 512 + lane * 8 + 4);
    uint2 uqn[2], ukn[2]; uint4 uvn[2]; bf16_t x1n[2], x2n[2];
#define RO_LOAD(t0_) do { const int ta_[2] = {(t0_), ((t0_) + nw < TT) ? (t0_) + nw : (t0_)}; \
        _Pragma("unroll") for (int e = 0; e < 2; ++e) { const bf16_t* zr = Z + (size_t)ta_[e] * NZ; \
            uqn[e] = *(const uint2*)(zr + ZCQ + lane * 4); ukn[e] = *(const uint2*)(zr + ZCKV + lane * 4); uvn[e] = *(const uint4*)(zr + ZCV + lane * 8); \
            x1n[e] = zr[ZKR + (lane & 15)]; x2n[e] = zr[ZKR + 16 + (lane & 15)]; } } while (0)
    if (gw < TT) RO_LOAD(gw);
    for (int tok0 = gw; tok0 < TT; tok0 += 2 * nw) {
        const bool has1 = tok0 + nw < TT; const int toks[2] = {tok0, has1 ? tok0 + nw : tok0};
        uint2 uq[2], uk[2]; uint4 uv[2]; float x1[2], x2[2];
#pragma unroll
        for (int e = 0; e < 2; ++e) { uq[e] = uqn[e]; uk[e] = ukn[e]; uv[e] = uvn[e]; x1[e] = bf2f(x1n[e]); x2[e] = bf2f(x2n[e]); }
        if (tok0 + 2 * nw < TT) RO_LOAD(tok0 + 2 * nw);
        f32x4 vq[2], vk[2], va[2], vc[2]; float sq[2], sk[2], sv[2];
#pragma unroll
        for (int e = 0; e < 2; ++e) { vq[e] = (f32x4){lo16(uq[e].x), hi16(uq[e].x), lo16(uq[e].y), hi16(uq[e].y)}; vk[e] = (f32x4){lo16(uk[e].x), hi16(uk[e].x), lo16(uk[e].y), hi16(uk[e].y)};
            va[e] = (f32x4){lo16(uv[e].x), hi16(uv[e].x), lo16(uv[e].y), hi16(uv[e].y)}; vc[e] = (f32x4){lo16(uv[e].z), hi16(uv[e].z), lo16(uv[e].w), hi16(uv[e].w)};
            sq[e] = vq[e][0] * vq[e][0] + vq[e][1] * vq[e][1] + vq[e][2] * vq[e][2] + vq[e][3] * vq[e][3];
            sk[e] = vk[e][0] * vk[e][0] + vk[e][1] * vk[e][1] + vk[e][2] * vk[e][2] + vk[e][3] * vk[e][3];
            sv[e] = va[e][0] + va[e][1] + va[e][2] + va[e][3] + vc[e][0] + vc[e][1] + vc[e][2] + vc[e][3]; }
#pragma unroll
        for (int e = 0; e < 2; ++e) { sq[e] = wave_sum(sq[e]); sk[e] = wave_sum(sk[e]); sv[e] = wave_sum(sv[e]); }
        float s2[2];
#pragma unroll
        for (int e = 0; e < 2; ++e) { const float mu = sv[e] * (1.0f / 512.0f); va[e] = va[e] - mu; vc[e] = vc[e] - mu;
            s2[e] = va[e][0] * va[e][0] + va[e][1] * va[e][1] + va[e][2] * va[e][2] + va[e][3] * va[e][3] + vc[e][0] * vc[e][0] + vc[e][1] * vc[e][1] + vc[e][2] * vc[e][2] + vc[e][3] * vc[e][3]; }
#pragma unroll
        for (int e = 0; e < 2; ++e) s2[e] = wave_sum(s2[e]);
#pragma unroll
        for (int e = 0; e < 2; ++e) {
            if (e == 1 && !has1) break;
            const int tok = toks[e]; bf16_t* zr = Z + (size_t)tok * NZ; const bool smp = tok >= TP; const int s = tok - TP;
            {   const f32x4 v = vq[e] * rsqrtf(sq[e] * (1.0f / 256.0f) + EPS) * gq; *(uint2*)(zr + ZCQ + lane * 4) = make_uint2(pk2(v[0], v[1]), pk2(v[2], v[3])); }
            {   const f32x4 v = vk[e] * rsqrtf(sk[e] * (1.0f / 256.0f) + EPS) * gk; *(uint2*)((bf16_t*)(p.ws + WS_CKVN) + (size_t)tok * 256 + lane * 4) = make_uint2(pk2(v[0], v[1]), pk2(v[2], v[3]));
                float* op = smp ? p.out + O_CKVS + ((size_t)l * TS + s) * 256 : p.out + O_CKVP + ((size_t)l * TP + tok) * 256;
                __builtin_nontemporal_store(v, (f32x4*)(op + lane * 4)); }
            if (lane < 16) {
                const int pidx = smp ? SEQ + (s & 31) : (tok & (SEQ - 1));
                const f32x2 cs = *(const f32x2*)(rope + ((size_t)pidx * 16 + lane) * 2);
                const float o1 = x1[e] * cs[0] - x2[e] * cs[1], o2 = x2[e] * cs[0] + x1[e] * cs[1];
                float* op = smp ? p.out + O_KRS + ((size_t)l * TS + s) * 32 : p.out + O_KRP + ((size_t)l * TP + tok) * 32;
                op[lane] = o1; op[16 + lane] = o2;
                bf16_t* kb = smp ? KRS + ((size_t)(s >> 5) * KSS + PAST + (s & 31)) * 32 : KRB + (size_t)tok * 32;
                kb[lane] = f2bf(o1); kb[16 + lane] = f2bf(o2); }
            {   const float rs = rsqrtf(s2[e] * (1.0f / 512.0f) + EPS); const f32x4 a = va[e] * rs * lg0 + lb0, c = vc[e] * rs * lg1 + lb1;
                *(uint4*)(zr + ZCV + lane * 8) = pack8(a, c);
                if (smp) { float* op = p.out + O_VS + ((size_t)l * TS + s) * 512 + lane * 8; *(f32x4*)op = a; *(f32x4*)(op + 4) = c; } }
        }
    }
}
__device__ __forceinline__ void cache_conv(const Params& p, int l) {
    const size_t gt = (size_t)blockIdx.x * 512 + opaque_tid(), nth = (size_t)gridDim.x * 512;
    const float* src = p.in[2] + (size_t)l * 8 * PAST * 256; bf16_t* dst = (bf16_t*)(p.ws + WS_XB);
    constexpr size_t NC = (size_t)8 * PAST * 256 / 8;
    for (size_t i = gt; i < NC; i += 4 * nth) { f32x4 a[4], b[4];
#pragma unroll
        for (int e = 0; e < 4; ++e) { const size_t j = i + e * nth; if (j < NC) { a[e] = __builtin_nontemporal_load((const f32x4*)(src + j * 8)); b[e] = __builtin_nontemporal_load((const f32x4*)(src + j * 8 + 4)); } }
#pragma unroll
        for (int e = 0; e < 4; ++e) { const size_t j = i + e * nth; if (j < NC) *(uint4*)(dst + j * 8) = pack8(a[e], b[e]); } }
    const float* ks = p.in[3] + (size_t)l * 8 * PAST * 32; bf16_t* KRS = (bf16_t*)(p.ws + WS_KRS);
    for (size_t i = gt; i < (size_t)8 * PAST * 32 / 8; i += nth) { const f32x4 a = *(const f32x4*)(ks + i * 8), b = *(const f32x4*)(ks + i * 8 + 4);
        const size_t row = i >> 2, bb = row >> 12, key = row & 4095; *(uint4*)(KRS + (bb * KSS + key) * 32 + (i & 3) * 8) = pack8(a, b); }
}

__device__ __forceinline__ void hg_item(int it, int& tok0, int& nrows, int& b, int& h) {
    if (it < 1024) { const int sq = it >> 5, c = it & 31; b = sq >> 2; h = sq & 3; tok0 = b * SEQ + c * 64; nrows = 64; }
    else { const int si = it - 1024; b = si >> 2; h = si & 3; tok0 = TP + b * DSEQ; nrows = 32; }
}
__device__ __forceinline__ void hg_stage(bf16_t* dst, const bf16_t* Z, int tok0, int nrows, int col, int tid) {
#pragma unroll
    for (int i = 0; i < 2; ++i) { const int c = tid + 512 * i, row = c >> 4, seg = c & 15; uint4 v = make_uint4(0, 0, 0, 0);
        if (row < nrows) v = *(const uint4*)(Z + (size_t)(tok0 + row) * NZ + col + seg * 8);
        *(uint4*)(dst + row * 136 + seg * 8) = v; }
}
__device__ __forceinline__ void hg_fetch(const bf16_t* Z, int it, int l, int tid, uint4 (&pf)[4]) {
    int tok0, nrows, b, h; hg_item(it, tok0, nrows, b, h);
#pragma unroll
    for (int i = 0; i < 2; ++i) { const int c = tid + 512 * i, row = c >> 4, seg = c & 15; pf[i] = make_uint4(0, 0, 0, 0); pf[2 + i] = make_uint4(0, 0, 0, 0);
        if (row < nrows) { const bf16_t* zr = Z + (size_t)(tok0 + row) * NZ + h * 128 + seg * 8; pf[i] = *(const uint4*)(zr + ZHF); pf[2 + i] = *(const uint4*)(zr + ZHI); } }
}
__device__ __forceinline__ void hg_store16(bf16_t* dst, const float (&x)[16]) {
    uint4 a, b; a.x = pk2(x[0], x[1]); a.y = pk2(x[2], x[3]); a.z = pk2(x[4], x[5]); a.w = pk2(x[6], x[7]); b.x = pk2(x[8], x[9]); b.y = pk2(x[10], x[11]); b.z = pk2(x[12], x[13]); b.w = pk2(x[14], x[15]);
    *(uint4*)dst = a; *(uint4*)(dst + 8) = b;
}
__device__ __forceinline__ void hgrn_pass1(unsigned char* smem, const Params& p, int l, int it, uint4 (&pf)[4], int nxt) {
    const int tid = opaque_tid(), lane = tid & 63, w = tid >> 6, fr = lane & 15, fq = lane >> 4;
    int tok0, nrows, b, h; hg_item(it, tok0, nrows, b, h);
    const bf16_t* Z = (const bf16_t*)(p.ws + WS_Z);
    bf16_t* Zf = (bf16_t*)smem;
    bf16_t* Zi = Zf + 64 * 136;
    bf16_t* KdT = Zi + 64 * 136;
    bf16_t* VT = KdT + 128 * 72;
    float* tot = (float*)(VT + 128 * 72);
#pragma unroll
    for (int i = 0; i < 2; ++i) { const int c = tid + 512 * i, row = c >> 4, seg = c & 15; *(uint4*)(Zf + row * 136 + seg * 8) = pf[i]; *(uint4*)(Zi + row * 136 + seg * 8) = pf[2 + i]; }
    __syncthreads();
    if (nxt < 1056) hg_fetch(Z, nxt, l, tid, pf);
    const int k = tid & 127, part = tid >> 7; const float lb = ((const float*)(p.ws + WS_LB))[l * 512 + h * 128 + k];
    float cs[16], kk[16], vv[16]; float run = 0.f;
#pragma unroll
    for (int i = 0; i < 16; ++i) { const int t = part * 16 + i;
        if (t < nrows) { const float sg = sigmoidf_(bf2f(Zf[t * 136 + k])); run += __logf(lb + (1.0f - lb) * sg + 1e-30f); kk[i] = (1.0f - lb) * (1.0f - sg); }
        else kk[i] = 0.f;
        vv[i] = bf2f(Zi[t * 136 + k]); cs[i] = run; }
    tot[part * 128 + k] = run;
    hg_store16(VT + k * 72 + part * 16, vv);
    __syncthreads();
    float pre = 0.f, bL = 0.f;
#pragma unroll
    for (int q = 0; q < 4; ++q) { const float tv = tot[q * 128 + k]; bL += tv; if (q < part) pre += tv; }
#pragma unroll
    for (int i = 0; i < 16; ++i) kk[i] = kk[i] * __expf(bL - (pre + cs[i]));
    hg_store16(KdT + k * 72 + part * 16, kk);
    if (part == 0) ((float*)(p.ws + WS_HD))[(size_t)it * 128 + k] = __expf(bL);
    __syncthreads();
    bf16x8 vf[2];
#pragma unroll
    for (int ks = 0; ks < 2; ++ks) vf[ks] = *(const bf16x8*)(VT + (16 * w + fr) * 72 + ks * 32 + fq * 8);
    bf16_t* HS = (bf16_t*)(p.ws + WS_HS) + (size_t)it * 16384;
#pragma unroll
    for (int nt = 0; nt < 8; ++nt) { f32x4 acc = {0.f, 0.f, 0.f, 0.f};
#pragma unroll
        for (int ks = 0; ks < 2; ++ks) { const bf16x8 kf = *(const bf16x8*)(KdT + (16 * nt + fr) * 72 + ks * 32 + fq * 8); acc = mfma16(kf, vf[ks], acc); }
        *(uint2*)(HS + (size_t)(16 * w + fr) * 128 + 16 * nt + 4 * fq) = make_uint2(pk2(acc[0], acc[1]), pk2(acc[2], acc[3])); }
    __syncthreads();
}
__device__ __forceinline__ void hgrn_scan(const Params& p, int l, int item) {
    const int tid = opaque_tid(), sq = item >> 4, vb = item & 15, v = vb * 8 + (tid >> 6), k0 = (tid & 63) * 2;
    bf16_t* HS = (bf16_t*)(p.ws + WS_HS); const float* HD = (const float*)(p.ws + WS_HD);
    if (sq < 32) { const int b = sq >> 2, h = sq & 3, it0 = sq * 32; float* outp = p.out + O_HSP + (size_t)((l * 8 + b) * 4 + h) * 16384;
        unsigned u[32]; f32x2 d[32];
#pragma unroll
        for (int c = 0; c < 32; ++c) { u[c] = *(const unsigned*)(HS + (size_t)(it0 + c) * 16384 + v * 128 + k0); d[c] = *(const f32x2*)(HD + (size_t)(it0 + c) * 128 + k0); }
        float r0 = 0.f, r1 = 0.f;
#pragma unroll
        for (int c = 0; c < 32; ++c) { *(unsigned*)(HS + (size_t)(it0 + c) * 16384 + v * 128 + k0) = pk2(r0, r1); r0 = d[c][0] * r0 + lo16(u[c]); r1 = d[c][1] * r1 + hi16(u[c]); }
        outp[(size_t)k0 * 128 + v] = r0; outp[(size_t)(k0 + 1) * 128 + v] = r1;
    } else { const int si = sq - 32, b = si >> 2, h = si & 3, it0 = 1024 + si; float* outp = p.out + O_HSS + (size_t)((l * 8 + b) * 4 + h) * 16384;
        const float* st = p.in[4] + (size_t)((l * 8 + b) * 4 + h) * 16384;
        float r0 = st[(size_t)k0 * 128 + v], r1 = st[(size_t)(k0 + 1) * 128 + v];
        bf16_t* hp = HS + (size_t)it0 * 16384 + v * 128 + k0; const unsigned u = *(const unsigned*)hp; const f32x2 d = *(const f32x2*)(HD + (size_t)it0 * 128 + k0);
        *(unsigned*)hp = pk2(r0, r1); r0 = d[0] * r0 + lo16(u); r1 = d[1] * r1 + hi16(u);
        outp[(size_t)k0 * 128 + v] = r0; outp[(size_t)(k0 + 1) * 128 + v] = r1; }
}
__device__ __forceinline__ void hgrn_pass3(unsigned char* smem, const Params& p, int l, int it) {
    const int tid = opaque_tid(), lane = tid & 63, w = tid >> 6, fr = lane & 15, fq = lane >> 4;
    int tok0, nrows, b, h; hg_item(it, tok0, nrows, b, h);
    const bf16_t* Z = (const bf16_t*)(p.ws + WS_Z);
    bf16_t* Qp = (bf16_t*)smem;
    bf16_t* Kp = Qp + 64 * 136;
    bf16_t* Qs = Kp + 64 * 136;
    bf16_t* Zi = Qs + 64 * 136;
    bf16_t* Zg = Zi + 64 * 136;
    bf16_t* VT = Zg + 64 * 136;
    bf16_t* Ab = VT + 128 * 72;
    float* tot = (float*)(Ab + 64 * 72);
    float* rss = tot + 512;
    const bf16_t* HS = (const bf16_t*)(p.ws + WS_HS) + (size_t)it * 16384;
    bf16x8 sf[4];
#pragma unroll
    for (int ks = 0; ks < 4; ++ks) sf[ks] = *(const bf16x8*)(HS + (size_t)(16 * w + fr) * 128 + ks * 32 + fq * 8);
    hg_stage(Qp, Z, tok0, nrows, ZHQ + h * 128, tid); hg_stage(Kp, Z, tok0, nrows, ZHF + h * 128, tid);
    hg_stage(Zi, Z, tok0, nrows, ZHI + h * 128, tid); hg_stage(Zg, Z, tok0, nrows, ZHG + h * 128, tid);
    __syncthreads();
    const int k = tid & 127, part = tid >> 7; const float lb = ((const float*)(p.ws + WS_LB))[l * 512 + h * 128 + k];
    float cs[16], kk[16], qv[16]; float run = 0.f;
    {   float vv[16];
#pragma unroll
        for (int i = 0; i < 16; ++i) { const int t = part * 16 + i;
            if (t < nrows) { const float sg = sigmoidf_(bf2f(Kp[t * 136 + k])); run += __logf(lb + (1.0f - lb) * sg + 1e-30f); kk[i] = (1.0f - lb) * (1.0f - sg); }
            else kk[i] = 0.f;
            qv[i] = bf2f(Qp[t * 136 + k]); vv[i] = bf2f(Zi[t * 136 + k]); cs[i] = run; }
        hg_store16(VT + k * 72 + part * 16, vv); }
    tot[part * 128 + k] = run;
    __syncthreads();
    float pre = 0.f; const float bmid = tot[k] + tot[128 + k];
#pragma unroll
    for (int q = 0; q < 4; ++q) if (q < part) pre += tot[q * 128 + k];
#pragma unroll
    for (int i = 0; i < 16; ++i) { const int t = part * 16 + i; const float bt = pre + cs[i];
        Qp[t * 136 + k] = f2bf(qv[i] * __expf(fminf(bt - bmid, 80.f))); Kp[t * 136 + k] = f2bf(kk[i] * __expf(fminf(bmid - bt, 80.f))); Qs[t * 136 + k] = f2bf(qv[i] * __expf(bt)); }
    __syncthreads();
    {   const int tm = w >> 1;
#pragma unroll
        for (int q = 0; q < 2; ++q) { const int sn = (w & 1) * 2 + q; f32x4 acc = {0.f, 0.f, 0.f, 0.f};
            if (sn <= tm) {
#pragma unroll
                for (int ks = 0; ks < 4; ++ks) { const bf16x8 a = *(const bf16x8*)(Qp + (16 * tm + fr) * 136 + ks * 32 + fq * 8), bb = *(const bf16x8*)(Kp + (16 * sn + fr) * 136 + ks * 32 + fq * 8); acc = mfma16(a, bb, acc); } }
#pragma unroll
            for (int j = 0; j < 4; ++j) { const int t = 16 * tm + 4 * fq + j, s2 = 16 * sn + fr; Ab[t * 72 + s2] = (s2 <= t && sn <= tm) ? f2bf(acc[j]) : (bf16_t)0; } }
    }
    __syncthreads();
    f32x4 o[4];
#pragma unroll
    for (int mt = 0; mt < 4; ++mt) o[mt] = (f32x4){0.f, 0.f, 0.f, 0.f};
#pragma unroll
    for (int ks = 0; ks < 2; ++ks) { const bf16x8 vf = *(const bf16x8*)(VT + (16 * w + fr) * 72 + ks * 32 + fq * 8);
#pragma unroll
        for (int mt = 0; mt < 4; ++mt) { const bf16x8 a = *(const bf16x8*)(Ab + (16 * mt + fr) * 72 + ks * 32 + fq * 8); o[mt] = mfma16(a, vf, o[mt]); } }
#pragma unroll
    for (int ks = 0; ks < 4; ++ks) {
#pragma unroll
        for (int mt = 0; mt < 4; ++mt) { const bf16x8 a = *(const bf16x8*)(Qs + (16 * mt + fr) * 136 + ks * 32 + fq * 8); o[mt] = mfma16(a, sf[ks], o[mt]); } }
#pragma unroll
    for (int mt = 0; mt < 4; ++mt)
#pragma unroll
        for (int j = 0; j < 4; ++j) { const float s2 = row16_sum(o[mt][j] * o[mt][j]);
            if (fr == 0) rss[(16 * mt + 4 * fq + j) * 8 + w] = s2; }
    __syncthreads();
    const float gn = p.in[14][l * 512 + h * 128 + 16 * w + fr];
#pragma unroll
    for (int mt = 0; mt < 4; ++mt)
#pragma unroll
        for (int j = 0; j < 4; ++j) { const int t = 16 * mt + 4 * fq + j;
            const f32x4 r0 = *(const f32x4*)(rss + t * 8), r1 = *(const f32x4*)(rss + t * 8 + 4);
            const float rs = rsqrtf((r0[0] + r0[1] + r0[2] + r0[3] + r1[0] + r1[1] + r1[2] + r1[3]) * (1.0f / 128.0f) + EPS);
            const float hg = bf2f(Zg[t * 136 + 16 * w + fr]);
            Qs[t * 136 + 16 * w + fr] = f2bf(o[mt][j] * rs * gn * hg * sigmoidf_(hg)); }
    __syncthreads();
    bf16_t* OC = (bf16_t*)(p.ws + WS_OCAT);
#pragma unroll
    for (int i = 0; i < 2; ++i) { const int c = tid + 512 * i, row = c >> 4, seg = c & 15;
        if (row < nrows) *(uint4*)(OC + (size_t)(tok0 + row) * 1536 + 512 + h * 128 + seg * 8) = *(const uint4*)(Qs + row * 136 + seg * 8); }
    __syncthreads();
}

__device__ __forceinline__ void cmlp_item(unsigned char* smem, const Params& p, int l, int item) {
    const int tid = opaque_tid(), lane = tid & 63, w = tid >> 6, fr = lane & 15, fq = lane >> 4;
    const int ch = item >> 2, g = item & 3; int tok0, nrows;
    if (ch < 128) { tok0 = ch * 128; nrows = 128; } else { tok0 = TP + (ch - 128) * DSEQ; nrows = 32; }
    const bf16_t* Z = (const bf16_t*)(p.ws + WS_Z);
    bf16_t* Vr = (bf16_t*)smem;
    bf16_t* VcT = Vr + 128 * 136;
    bf16_t* Wl = VcT + 128 * 136;
#pragma unroll
    for (int q = 0; q < 4; ++q) { const int c = tid + 512 * q, row = c >> 4, seg = c & 15; uint4 v = make_uint4(0, 0, 0, 0);
        if (row < nrows) v = *(const uint4*)(Z + (size_t)(tok0 + row) * NZ + ZCV + g * 128 + seg * 8);
        *(uint4*)(Vr + row * 136 + seg * 8) = v; }
    {   const int i = tid >> 2, j0 = (tid & 3) * 32; const float* wp = p.in[17] + ((size_t)(l * 4 + g) * 128 + i) * 128 + j0;
#pragma unroll
        for (int q = 0; q < 4; ++q) { f32x4 a = *(const f32x4*)(wp + q * 8), bb = *(const f32x4*)(wp + q * 8 + 4);
#pragma unroll
            for (int e = 0; e < 4; ++e) { if (j0 + q * 8 + e > i) a[e] = 0.f; if (j0 + q * 8 + 4 + e > i) bb[e] = 0.f; }
            *(uint4*)(Wl + i * 136 + j0 + q * 8) = pack8(a, bb); } }
    __syncthreads();
    {   const int c = tid & 127, part = tid >> 7;
#pragma unroll
        for (int q = 0; q < 4; ++q) { unsigned short e[8];
#pragma unroll
            for (int i = 0; i < 8; ++i) e[i] = Vr[(part * 32 + q * 8 + i) * 136 + c];
            uint4 o; o.x = e[0] | ((unsigned)e[1] << 16); o.y = e[2] | ((unsigned)e[3] << 16); o.z = e[4] | ((unsigned)e[5] << 16); o.w = e[6] | ((unsigned)e[7] << 16);
            *(uint4*)(VcT + c * 136 + part * 32 + q * 8) = o; } }
    __syncthreads();
    uint4 ur[4];
#pragma unroll
    for (int q = 0; q < 4; ++q) { const int c = tid + 512 * q, row = c >> 4, seg = c & 15; ur[q] = make_uint4(0, 0, 0, 0);
        if (row < nrows) ur[q] = *(const uint4*)(Z + (size_t)(tok0 + row) * NZ + ZCU + g * 128 + seg * 8); }
    const bool act = 16 * w < nrows;
    f32x4 acc[8];
    if (act) {
        bf16x8 af[4];
#pragma unroll
        for (int ks = 0; ks < 4; ++ks) af[ks] = *(const bf16x8*)(Wl + (16 * w + fr) * 136 + ks * 32 + fq * 8);
#pragma unroll
        for (int nt = 0; nt < 8; ++nt) { acc[nt] = (f32x4){0.f, 0.f, 0.f, 0.f};
#pragma unroll
            for (int ks = 0; ks < 4; ++ks) { const bf16x8 bb = *(const bf16x8*)(VcT + (16 * nt + fr) * 136 + ks * 32 + fq * 8); acc[nt] = mfma16(af[ks], bb, acc[nt]); } }
    }
#pragma unroll
    for (int q = 0; q < 4; ++q) { const int c = tid + 512 * q, row = c >> 4, seg = c & 15; *(uint4*)(Vr + row * 136 + seg * 8) = ur[q]; }
    __syncthreads();
    if (act) {
        float bias[4];
#pragma unroll
        for (int j = 0; j < 4; ++j) bias[j] = p.in[18][(size_t)(l * 4 + g) * 128 + 16 * w + 4 * fq + j];
#pragma unroll
        for (int nt = 0; nt < 8; ++nt)
#pragma unroll
            for (int j = 0; j < 4; ++j) { bf16_t* e = Vr + (16 * w + 4 * fq + j) * 136 + 16 * nt + fr; *e = f2bf(bf2f(*e) * (acc[nt][j] + bias[j])); }
    }
    __syncthreads();
    bf16_t* OC = (bf16_t*)(p.ws + WS_OCAT);
#pragma unroll
    for (int q = 0; q < 4; ++q) { const int c = tid + 512 * q, row = c >> 4, seg = c & 15;
        if (row < nrows) *(uint4*)(OC + (size_t)(tok0 + row) * 1536 + 1024 + g * 128 + seg * 8) = *(const uint4*)(Vr + row * 136 + seg * 8); }
    __syncthreads();
}

typedef unsigned u32x4 __attribute__((ext_vector_type(4)));
typedef unsigned u32x2 __attribute__((ext_vector_type(2)));
__device__ __forceinline__ void attn_item(unsigned char* smem, const Params& p, int item) {
    const int tid = opaque_tid(), lane = tid & 63, w = tid >> 6, fr = lane & 15, fq = lane >> 4;
    const bf16_t* Qb = (const bf16_t*)(p.ws + WS_Q);
    const int x = item - 64, i = 7 - (x >> 6), bh = x & 63, b = bh >> 3, h = bh & 7;
    const int qtok0 = b * SEQ + i * 256, nks = 2 * i + 2, wlim = 4 * i + (w >> 1) + 1;
    const bf16_t* kn = (const bf16_t*)(p.ws + WS_KN) + (size_t)b * SEQ * 512 + h * 64; const bf16_t* kr = (const bf16_t*)(p.ws + WS_KRB) + (size_t)b * SEQ * 32;
    const bf16_t* vt = (const bf16_t*)(p.ws + WS_VT) + (size_t)(b * 512 + h * 64) * SEQ;
    LAS unsigned char* L = (LAS unsigned char*)smem;
    constexpr int KSB = 128 * 208, VSB = 64 * 272, BUFB = KSB + VSB;
    bf16x8 qf[2][3];
#pragma unroll
    for (int qt = 0; qt < 2; ++qt) { const bf16_t* qp = Qb + (size_t)(qtok0 + 32 * w + 16 * qt + fr) * 768 + h * 96;
#pragma unroll
        for (int ks = 0; ks < 3; ++ks) qf[qt][ks] = *(const bf16x8*)(qp + ks * 32 + fq * 8); }
    f32x4 o[2][4]; float mrow[2], lrow[2];
#pragma unroll
    for (int qt = 0; qt < 2; ++qt) { mrow[qt] = -1e30f; lrow[qt] = 0.f;
#pragma unroll
        for (int d = 0; d < 4; ++d) o[qt][d] = (f32x4){0.f, 0.f, 0.f, 0.f}; }
    u32x4 rk0, rk1, rr, rv0, rv1;
    const int kr0 = tid >> 3, ksg = tid & 7, rrw = tid >> 2, rsg = tid & 3, vr0 = tid >> 4, vsg = tid & 15;
    const unsigned wk0 = kr0 * 208 + ksg * 16, wk1 = (kr0 + 64) * 208 + ksg * 16, wrr = rrw * 208 + 128 + rsg * 16, wv0 = KSB + vr0 * 272 + vsg * 16, wv1 = KSB + (vr0 + 32) * 272 + vsg * 16;
#define ATT_LOAD(k0) do { rk0 = *(const u32x4*)(kn + (size_t)((k0) + kr0) * 512 + ksg * 8); rk1 = *(const u32x4*)(kn + (size_t)((k0) + kr0 + 64) * 512 + ksg * 8); \
        rr = *(const u32x4*)(kr + (size_t)((k0) + rrw) * 32 + rsg * 8); rv0 = *(const u32x4*)(vt + (size_t)vr0 * SEQ + (k0) + vsg * 8); rv1 = *(const u32x4*)(vt + (size_t)(vr0 + 32) * SEQ + (k0) + vsg * 8); } while (0)
#define ATT_STORE(buf) do { LAS unsigned char* B_ = L + (buf) * BUFB; *(LAS u32x4*)(B_ + wk0) = rk0; *(LAS u32x4*)(B_ + wk1) = rk1; *(LAS u32x4*)(B_ + wrr) = rr; *(LAS u32x4*)(B_ + wv0) = rv0; *(LAS u32x4*)(B_ + wv1) = rv1; } while (0)
    ATT_LOAD(0); ATT_STORE(0);
    __syncthreads();
    if (nks > 1) ATT_LOAD(128);
    if (__builtin_amdgcn_readfirstlane(tid) >= 256) __builtin_amdgcn_s_setprio(1);
    for (int ks2 = 0; ks2 < nks; ++ks2) {
        if (ks2 + 1 < nks) ATT_STORE((ks2 + 1) & 1);
        if (ks2 + 2 < nks) ATT_LOAD((ks2 + 2) * 128);
        if (2 * ks2 < wlim) {
            const LAS unsigned char* KB = L + (ks2 & 1) * BUFB; const LAS unsigned char* VB = KB + KSB;
            f32x4 s[2][8];
#pragma unroll
            for (int nt = 0; nt < 8; ++nt) { s[0][nt] = (f32x4){0.f, 0.f, 0.f, 0.f}; s[1][nt] = (f32x4){0.f, 0.f, 0.f, 0.f};
#pragma unroll
                for (int ks = 0; ks < 3; ++ks) { const bf16x8 kf = *(const LAS bf16x8*)(KB + (16 * nt + fr) * 208 + ks * 64 + fq * 16);
                    s[0][nt] = mfma16(kf, qf[0][ks], s[0][nt]); s[1][nt] = mfma16(kf, qf[1][ks], s[1][nt]); } }
            if (2 * ks2 + 1 >= wlim) {
#pragma unroll
                for (int nt = 4; nt < 8; ++nt) { s[0][nt] = (f32x4){-1e30f, -1e30f, -1e30f, -1e30f}; s[1][nt] = (f32x4){-1e30f, -1e30f, -1e30f, -1e30f}; } }
            bf16x8 pb[2][4];
#pragma unroll
            for (int qt = 0; qt < 2; ++qt) {
                float mx = -1e30f;
#pragma unroll
                for (int nt = 0; nt < 8; ++nt) mx = fmaxf(mx, fmaxf(fmaxf(s[qt][nt][0], s[qt][nt][1]), fmaxf(s[qt][nt][2], s[qt][nt][3])));
                mx = xr32_max(xr16_max(mx));
                float mn = mrow[qt], al = 1.0f;
                if (__builtin_amdgcn_ballot_w64(mx - mn > 8.0f) != 0ull) { mn = fmaxf(mn, mx); al = __builtin_amdgcn_exp2f(mrow[qt] - mn); mrow[qt] = mn;
#pragma unroll
                    for (int dn = 0; dn < 4; ++dn) o[qt][dn] = o[qt][dn] * al; }
                float ps = 0.f;
#pragma unroll
                for (int nt = 0; nt < 8; ++nt)
#pragma unroll
                    for (int j = 0; j < 4; ++j) { const float pv = __builtin_amdgcn_exp2f(s[qt][nt][j] - mn); s[qt][nt][j] = pv; ps += pv; }
                lrow[qt] = lrow[qt] * al + ps;
#pragma unroll
                for (int t = 0; t < 4; ++t) { const u32x4 u = {pk2(s[qt][2 * t][0], s[qt][2 * t][1]), pk2(s[qt][2 * t][2], s[qt][2 * t][3]), pk2(s[qt][2 * t + 1][0], s[qt][2 * t + 1][1]), pk2(s[qt][2 * t + 1][2], s[qt][2 * t + 1][3])};
                    pb[qt][t] = __builtin_bit_cast(bf16x8, u); }
            }
#pragma unroll
            for (int t = 0; t < 4; ++t)
#pragma unroll
                for (int dn = 0; dn < 4; ++dn) { const LAS unsigned char* vp = VB + (16 * dn + fr) * 272 + (32 * t + 4 * fq) * 2;
                    const u32x2 v0 = *(const LAS u32x2*)vp, v1 = *(const LAS u32x2*)(vp + 32); const u32x4 u = {v0[0], v0[1], v1[0], v1[1]}; const bf16x8 vf = __builtin_bit_cast(bf16x8, u);
                    o[0][dn] = mfma16(vf, pb[0][t], o[0][dn]); o[1][dn] = mfma16(vf, pb[1][t], o[1][dn]); }
        }
        __syncthreads();
    }
#undef ATT_LOAD
#undef ATT_STORE
    __builtin_amdgcn_s_setprio(0);
    bf16_t* OC = (bf16_t*)(p.ws + WS_OCAT);
#pragma unroll
    for (int qt = 0; qt < 2; ++qt) { float ls = lrow[qt]; ls = xr32_sum(xr16_sum(ls)); const float inv = 1.0f / ls; const int r = 32 * w + 16 * qt + fr;
#pragma unroll
        for (int dn = 0; dn < 4; ++dn) { const f32x4 v = o[qt][dn] * inv; *(uint2*)(OC + (size_t)(qtok0 + r) * 1536 + h * 64 + 16 * dn + 4 * fq) = make_uint2(pk2(v[0], v[1]), pk2(v[2], v[3])); } }
}

__device__ __forceinline__ void attn_sample_item(unsigned char* smem, const Params& p, int item) {
    const int tid = opaque_tid(), lane = tid & 63, w = tid >> 6, fr = lane & 15, fq = lane >> 4;
    const int b = item >> 3, h = item & 7, qtok0 = TP + b * DSEQ;
    const bf16_t* kn = (const bf16_t*)(p.ws + WS_KNS) + (size_t)b * KSS * 512 + h * 64; const bf16_t* kr = (const bf16_t*)(p.ws + WS_KRS) + (size_t)b * KSS * 32;
    const bf16_t* vt = (const bf16_t*)(p.ws + WS_VTS) + (size_t)(b * 512 + h * 64) * KSS; const bf16_t* Qb = (const bf16_t*)(p.ws + WS_Q);
    bf16x8 qf[2][3];
#pragma unroll
    for (int qt = 0; qt < 2; ++qt) { const bf16_t* qp = Qb + (size_t)(qtok0 + 16 * qt + fr) * 768 + h * 96;
#pragma unroll
        for (int ks = 0; ks < 3; ++ks) qf[qt][ks] = *(const bf16x8*)(qp + ks * 32 + fq * 8); }
    f32x4 o[2][4]; float mrow[2], lrow[2];
#pragma unroll
    for (int qt = 0; qt < 2; ++qt) { mrow[qt] = -1e30f; lrow[qt] = 0.f;
#pragma unroll
        for (int i = 0; i < 4; ++i) o[qt][i] = (f32x4){0.f, 0.f, 0.f, 0.f}; }
    for (int kt = w; kt < 65; kt += 8) {
        const int k0 = kt * 64;
        f32x4 s[2][4];
#pragma unroll
        for (int nt = 0; nt < 4; ++nt) { s[0][nt] = (f32x4){0.f, 0.f, 0.f, 0.f}; s[1][nt] = (f32x4){0.f, 0.f, 0.f, 0.f};
            const size_t key = (size_t)(k0 + 16 * nt + fr);
#pragma unroll
            for (int ks = 0; ks < 3; ++ks) { const bf16x8 kf = (ks < 2) ? *(const bf16x8*)(kn + key * 512 + ks * 32 + fq * 8) : *(const bf16x8*)(kr + key * 32 + fq * 8);
                s[0][nt] = mfma16(kf, qf[0][ks], s[0][nt]); s[1][nt] = mfma16(kf, qf[1][ks], s[1][nt]); } }
        if (kt == 64) {
#pragma unroll
            for (int nt = 0; nt < 4; ++nt)
#pragma unroll
                for (int j = 0; j < 4; ++j) if (k0 + 16 * nt + 4 * fq + j >= PAST + DSEQ) { s[0][nt][j] = -1e30f; s[1][nt][j] = -1e30f; } }
        bf16x8 pb[2][2];
#pragma unroll
        for (int qt = 0; qt < 2; ++qt) {
            float mx = -1e30f;
#pragma unroll
            for (int nt = 0; nt < 4; ++nt) mx = fmaxf(mx, fmaxf(fmaxf(s[qt][nt][0], s[qt][nt][1]), fmaxf(s[qt][nt][2], s[qt][nt][3])));
            mx = xr32_max(xr16_max(mx));
            float mn = mrow[qt], al = 1.0f;
            if (__builtin_amdgcn_ballot_w64(mx - mn > 8.0f) != 0ull) { mn = fmaxf(mn, mx); al = __builtin_amdgcn_exp2f(mrow[qt] - mn); mrow[qt] = mn;
#pragma unroll
                for (int dn = 0; dn < 4; ++dn) o[qt][dn] = o[qt][dn] * al; }
            float ps = 0.f;
#pragma unroll
            for (int nt = 0; nt < 4; ++nt)
#pragma unroll
                for (int j = 0; j < 4; ++j) { const float pv = __builtin_amdgcn_exp2f(s[qt][nt][j] - mn); s[qt][nt][j] = pv; ps += pv; }
            lrow[qt] = lrow[qt] * al + ps;
#pragma unroll
            for (int t = 0; t < 2; ++t) { const u32x4 u = {pk2(s[qt][2 * t][0], s[qt][2 * t][1]), pk2(s[qt][2 * t][2], s[qt][2 * t][3]), pk2(s[qt][2 * t + 1][0], s[qt][2 * t + 1][1]), pk2(s[qt][2 * t + 1][2], s[qt][2 * t + 1][3])};
                pb[qt][t] = __builtin_bit_cast(bf16x8, u); }
        }
#pragma unroll
        for (int t = 0; t < 2; ++t)
#pragma unroll
            for (int dn = 0; dn < 4; ++dn) { const bf16_t* vp = vt + (size_t)(16 * dn + fr) * KSS + k0 + 32 * t + 4 * fq;
                const u32x2 v0 = *(const u32x2*)vp, v1 = *(const u32x2*)(vp + 16); const u32x4 u = {v0[0], v0[1], v1[0], v1[1]}; const bf16x8 vf = __builtin_bit_cast(bf16x8, u);
                o[0][dn] = mfma16(vf, pb[0][t], o[0][dn]); o[1][dn] = mfma16(vf, pb[1][t], o[1][dn]); }
    }
    float* Ow = (float*)smem; float* Mw = Ow + 8 * 32 * 68; float* Lw = Mw + 256;
#pragma unroll
    for (int qt = 0; qt < 2; ++qt) { float ls = lrow[qt]; ls = xr32_sum(xr16_sum(ls));
        if (fq == 0) { Mw[w * 32 + 16 * qt + fr] = mrow[qt]; Lw[w * 32 + 16 * qt + fr] = ls; }
#pragma unroll
        for (int dn = 0; dn < 4; ++dn) *(f32x4*)(Ow + (size_t)(w * 32 + 16 * qt + fr) * 68 + 16 * dn + 4 * fq) = o[qt][dn]; }
    __syncthreads();
    {   const int q = tid >> 4, d0 = (tid & 15) * 4; float M = -1e30f;
#pragma unroll
        for (int ww = 0; ww < 8; ++ww) M = fmaxf(M, Mw[ww * 32 + q]);
        f32x4 acc = {0.f, 0.f, 0.f, 0.f}; float L = 0.f;
#pragma unroll
        for (int ww = 0; ww < 8; ++ww) { const float sc = __builtin_amdgcn_exp2f(Mw[ww * 32 + q] - M); L += sc * Lw[ww * 32 + q]; acc = acc + *(const f32x4*)(Ow + (size_t)(ww * 32 + q) * 68 + d0) * sc; }
        const float inv = 1.0f / L; acc = acc * inv;
        *(uint2*)((bf16_t*)(p.ws + WS_OCAT) + (size_t)(qtok0 + q) * 1536 + h * 64 + d0) = make_uint2(pk2(acc[0], acc[1]), pk2(acc[2], acc[3])); }
    __syncthreads();
}

#define XB_TMO      128
#define XB_XCNT(j)  (256  + 64 * (j))
#define XB_XSUB(j)  (1280 + 64 * (j))
#define XB_XGEN(j)  (2304 + 64 * (j))
#define XB_TOP      3328
#define XB_TOPGEN   3392
#define XB_SPIN_CAP (1u << 20)
__device__ __forceinline__ unsigned xb_ld(unsigned* p)              { return __hip_atomic_load(p, __ATOMIC_RELAXED, __HIP_MEMORY_SCOPE_AGENT); }
__device__ __forceinline__ unsigned xb_add(unsigned* p, unsigned v) { return __hip_atomic_fetch_add(p, v, __ATOMIC_RELAXED, __HIP_MEMORY_SCOPE_AGENT); }
__device__ __forceinline__ unsigned xb_xcc_id() { return (unsigned)__builtin_amdgcn_s_getreg((3 << 11) | 20) & 0xFu; }
#define XB_SPIN(cond, bar) do { unsigned _sp = 0; while (cond) { __builtin_amdgcn_s_sleep(1); \
    if ((++_sp & 255u) == 0u) { if (xb_ld(&(bar)[XB_TMO])) break; if (_sp > XB_SPIN_CAP) { atomicAdd(&(bar)[XB_TMO], 1u); break; } } } } while (0)
struct XcdBarrier { unsigned* bar; unsigned x; volatile LAS unsigned* st; };
__device__ __forceinline__ XcdBarrier xcd_barrier_post(unsigned* bar, volatile LAS unsigned* st) {
    XcdBarrier b; b.bar = bar; b.x = xb_xcc_id(); b.st = st;
    if (threadIdx.x == 0) (void)xb_add(&bar[XB_XCNT(b.x)], 1u);
    return b;
}
__device__ __forceinline__ void xcd_barrier_complete(unsigned* bar, unsigned x, unsigned& nloc, unsigned& nx) {
    const unsigned G = gridDim.x * gridDim.y * gridDim.z;
    unsigned sum, cnt, mine, sp = 0u;
    for (;;) {
        sum = 0u; cnt = 0u; mine = 0u;
#pragma unroll
        for (unsigned j = 0; j < 16; ++j) { const unsigned c = xb_ld(&bar[XB_XCNT(j)]); sum += c; cnt += (c > 0u) ? 1u : 0u; mine = (j == x) ? c : mine; }
        if (sum == G) break;
        __builtin_amdgcn_s_sleep(1);
        if ((++sp & 255u) == 0u) { if (xb_ld(&bar[XB_TMO])) break; if (sp > XB_SPIN_CAP) { atomicAdd(&bar[XB_TMO], 1u); break; } }
    }
    nloc = mine > 0u ? mine : 1u; nx = cnt > 0u ? cnt : 1u;
}
__device__ __forceinline__ void xcd_barrier(const XcdBarrier& b) {
    asm volatile("s_waitcnt vmcnt(0)" ::: "memory");
    __syncthreads();
    if (threadIdx.x == 0) {
        unsigned* bar = b.bar;
        __builtin_amdgcn_s_waitcnt(0);
        unsigned nloc = b.st[0], nx = b.st[1];
        if (nloc == 0u) { xcd_barrier_complete(bar, b.x, nloc, nx); b.st[0] = nloc; b.st[1] = nx; }
        const unsigned old = xb_add(&bar[XB_XSUB(b.x)], 1u);
        const unsigned gen = old / nloc;
        if (old + 1u == (gen + 1u) * nloc) {
            __builtin_amdgcn_fence(__ATOMIC_RELEASE, "agent");
            asm volatile("s_waitcnt vmcnt(0)" ::: "memory");
            const unsigned og = xb_add(&bar[XB_TOP], 1u);
            const unsigned tg = og / nx;
            if (og + 1u == (tg + 1u) * nx) xb_add(&bar[XB_TOPGEN], 1u);
            else XB_SPIN(xb_ld(&bar[XB_TOPGEN]) == tg, bar);
            __builtin_amdgcn_fence(__ATOMIC_ACQUIRE, "agent");
            xb_add(&bar[XB_XGEN(b.x)], 1u);
            asm volatile("s_waitcnt vmcnt(0)" ::: "memory");
        } else {
            XB_SPIN(xb_ld(&bar[XB_XGEN(b.x)]) == gen, bar);
            __builtin_amdgcn_fence(__ATOMIC_ACQUIRE, "agent");
            asm volatile("s_waitcnt vmcnt(0)" ::: "memory");
        }
    }
    __syncthreads();
}

__device__ __forceinline__ void prologue(unsigned char* smem, const Params& p) {
    const size_t gt = (size_t)blockIdx.x * 512 + opaque_tid();
    if (gt < 2080 * 16) { const int pidx = (int)(gt >> 4), i = (int)(gt & 15); const float pos = (float)(pidx < SEQ ? pidx : PAST + pidx - SEQ);
        const float inv = 1.0f / powf(10000.0f, (float)i / 16.0f); float sn, cs; sincosf(pos * inv, &sn, &cs);
        float* rp = (float*)(p.ws + WS_ROPE) + gt * 2; rp[0] = cs; rp[1] = sn; }
    if (gt < 512) { const float* hb = p.in[13]; const float a0 = hb[gt], a1 = hb[512 + gt], a2 = hb[1024 + gt], a3 = hb[1536 + gt]; const float mx = fmaxf(fmaxf(a0, a1), fmaxf(a2, a3));
        const float e0 = expf(a0 - mx), e1 = expf(a1 - mx), e2 = expf(a2 - mx), e3 = expf(a3 - mx), inv = 1.0f / (e0 + e1 + e2 + e3);
        float* lb = (float*)(p.ws + WS_LB); lb[gt] = 0.f; lb[512 + gt] = e1 * inv; lb[1024 + gt] = (e1 + e2) * inv; lb[1536 + gt] = (e1 + e2 + e3) * inv; }
    ln_rows(p.in[0], p.in[1], p.out + O_YP, (bf16_t*)(p.ws + WS_XB), p.in[5], p.in[6], nullptr, true);
    conv_layer(smem, p, 0);
}

template <int KSEL> __device__ __forceinline__ void run_phase(unsigned char* smem, const Params& p, int ph) {
    if (ph == 0) { if (KSEL < 0 || KSEL == 10) prologue(smem, p); return; }
    const int rep = ph >= 1000 ? 1 : 0; ph = ph % 1000; const int l = (ph - 1) / 10, k = (KSEL >= 20) ? 2 : (KSEL >= 0 && KSEL < 10) ? KSEL : (ph - 1) % 10;
    if (KSEL == 10) return;
    const bf16_t* W = (const bf16_t*)(p.ws + WS_WT);
    bf16_t* Z = (bf16_t*)(p.ws + WS_Z); bf16_t* XB = (bf16_t*)(p.ws + WS_XB); bf16_t* OC = (bf16_t*)(p.ws + WS_OCAT);
    float* X = p.out + O_YP; float* ST = (float*)(p.ws + WS_ST);
    const int G = gridDim.x, bid = blockIdx.x;
    switch (k) {
    case 0: { EpiZ e; e.Z = Z; run_gemm(smem, XB, 1024, W + W_IN, 1024, TT, NZ, 1024, 0, e); } break;
    case 1: {
        rowops(p, l); cache_conv(p, l);
        {   uint4 pf[4]; const int t0 = opaque_tid(); if (bid < 1056) hg_fetch((const bf16_t*)(p.ws + WS_Z), bid, l, t0, pf);
            for (int it = bid; it < 1056; it += G) hgrn_pass1(smem, p, l, it, pf, it + G); }
    } break;
    case 2: {
        if (KSEL < 20 || KSEL == 20) { EpiQ e; e.Q = (bf16_t*)(p.ws + WS_Q); e.rope = (const float*)(p.ws + WS_ROPE); run_gemm(smem, Z + ZCQ, NZ, W + W_UQ, 256, TT, 768, 256, 0, e); }
        {   EpiKV4 e; e.kn0.KN = (bf16_t*)(p.ws + WS_KN); e.kn0.KNS = (bf16_t*)(p.ws + WS_KNS); e.kn0.mode = 0; e.kn1.KN = nullptr; e.kn1.KNS = e.kn0.KNS; e.kn1.mode = 1;
            e.vt0.VT = (bf16_t*)(p.ws + WS_VT); e.vt0.VTS = (bf16_t*)(p.ws + WS_VTS); e.vt0.mode = 0; e.vt1.VT = nullptr; e.vt1.VTS = e.vt0.VTS; e.vt1.mode = 1;
            int Kop = 256; asm volatile("" : "+s"(Kop));
            pg8::Gemm g; g.A = (const bf16_t*)p.ws; g.Bt = (const bf16_t*)p.ws; g.M = 0; g.N = 0; g.K = Kop; g.lda = 256; g.ldb = 256;
            const long oW = (long)(WS_WT + W_UKV * 2), oWv = oW + 512 * 256 * 2, oC = (long)WS_CKVN, oX = (long)WS_XB;
            KV4Order S; S.G = G; S.c = bid; S.oW = oW; S.oWv = oWv; S.oC = oC; S.oX = oX;
            pg8::gemm_phase<EpiKV4, KV4Order>((LAS unsigned char*)smem, g, S, e);
            __syncthreads(); }
        if (KSEL < 20 || KSEL == 25) for (int it = bid; it < 544; it += G) cmlp_item(smem, p, l, it);
#ifndef NO_SCAN
        if (KSEL < 20 || KSEL == 25) for (int it = bid; it < 1024; it += G) hgrn_scan(p, l, it);
#endif
    } break;
    case 3: {
        unsigned* ctr = (unsigned*)(p.ws + WS_CTL) + l; int* sitem = (int*)(smem + LDS_BYTES - 16);
        int nxt = 0; if (threadIdx.x == 0) nxt = (int)atomicAdd(ctr, 1u);
        for (;;) {
            if (threadIdx.x == 0) *sitem = nxt;
            __syncthreads(); const int it = *sitem;
            if (it >= 576 + 1056) break;
            if (threadIdx.x == 0) nxt = (int)atomicAdd(ctr, 1u);
            if (it < 64) attn_sample_item(smem, p, it); else if (it < 576) attn_item(smem, p, it); else hgrn_pass3(smem, p, l, it - 576);
        }
    } break;
    case 4: { EpiMerge e; e.Mo = XB; e.Z = Z; run_gemm(smem, OC, 1536, W + W_CAT, 1536, TP, 1024, 1536, 0, e); skinny_gemm<3, 1>(smem, p, OC, 1536, W + W_CAT, 1536, 512); } break;
    case 5: { EpiRes e; e.X = X; e.ST = l ? ST : nullptr; e.G = p.in[27] + (l ? l - 1 : 0) * 1024; e.B = p.in[28] + (l ? l - 1 : 0) * 1024; run_gemm(smem, XB, 1024, W + W_O, 1024, TP, 1024, 1024, 0, e); skinny_gemm<1, 0>(smem, p, XB, 1024, W + W_O, 1024, 1024, e.ST, e.G, e.B); } break;
    case 6: ln_rows(X, X + (size_t)TP * 1024, X, XB, p.in[23] + l * 1024, p.in[24] + l * 1024, ST, false); break;
    case 7: { EpiUp e; e.H = Z; run_gemm(smem, XB, 1024, W + W_UP, 1024, TT, 5632, 1024, 0, e); } break;
    case 8: { EpiRes e; e.X = X; e.ST = ST; e.G = p.in[23] + l * 1024; e.B = p.in[24] + l * 1024; run_gemm(smem, Z, DFF, W + W_DN, DFF, TP, 1024, DFF, 0, e); skinny_gemm<1, 0>(smem, p, Z, DFF, W + W_DN, DFF, DFF, e.ST, e.G, e.B); } break;
    case 9: { ln_rows(X, X + (size_t)TP * 1024, X, XB, p.in[27] + l * 1024, p.in[28] + l * 1024, ST, l + 1 == DEPTH); if (l + 1 < DEPTH) conv_layer(smem, p, l + 1); } break;
    }
}

__global__ void __launch_bounds__(512, 2) fwd_megakernel(Params p) {
    extern __shared__ __attribute__((aligned(16))) unsigned char shm[];
    volatile LAS unsigned* st = (volatile LAS unsigned*)(LAS unsigned char*)(shm + LDS_BYTES - 32);
    if (threadIdx.x == 0) { st[0] = 0u; st[1] = 0u; }
    __syncthreads();
    const XcdBarrier xb = xcd_barrier_post((unsigned*)(p.ws + WS_BAR), st);
    for (int ph = p.ph_lo; ph < p.ph_hi; ++ph) {
        run_phase<-1>(shm, p, ph);
        if (ph + 1 < p.ph_hi) { if (p.ph_lo < 0) cg::this_grid().sync();
            xcd_barrier(xb); }
    }
}
#ifdef TESTK
template <int KS> __global__ void __launch_bounds__(512, 2) test_k(Params p) { extern __shared__ __attribute__((aligned(16))) unsigned char shm[]; run_phase<KS>(shm, p, p.ph_lo); }
template __global__ void test_k<0>(Params); template __global__ void test_k<1>(Params); template __global__ void test_k<2>(Params); template __global__ void test_k<3>(Params);
template __global__ void test_k<4>(Params); template __global__ void test_k<5>(Params); template __global__ void test_k<6>(Params); template __global__ void test_k<7>(Params);
template __global__ void test_k<8>(Params); template __global__ void test_k<9>(Params); template __global__ void test_k<10>(Params); template __global__ void test_k<20>(Params); template __global__ void test_k<21>(Params); template __global__ void test_k<22>(Params); template __global__ void test_k<23>(Params); template __global__ void test_k<24>(Params); template __global__ void test_k<25>(Params);
#endif
extern "C" void kernel_launch(void* const* d_in, const int* in_sizes, int n_in, void* d_out, int out_size, void* d_ws, size_t ws_size, hipStream_t stream) {
    static int grid = 0;
    if (grid == 0) {
        int dev = 0, cus = 0, per_cu = 0;
        hipGetDevice(&dev); hipDeviceGetAttribute(&cus, hipDeviceAttributeMultiprocessorCount, dev);
        hipFuncSetAttribute((const void*)fwd_megakernel, hipFuncAttributeMaxDynamicSharedMemorySize, LDS_BYTES);
        hipOccupancyMaxActiveBlocksPerMultiprocessor(&per_cu, (const void*)fwd_megakernel, 512, LDS_BYTES);
        (void)hipGetLastError();
        if (per_cu < 1) per_cu = 1;
        grid = cus;
        if (ws_size < WS_END) { fprintf(stderr, "kernel_launch: workspace too small: %zu < %zu\n", ws_size, (size_t)WS_END); grid = -1; }
    }
    if (grid < 0) return;
    (void)hipMemsetAsync((char*)d_ws + WS_CTL, 0, 32768, stream);
    Params p{};
    for (int i = 0; i < 29; ++i) p.in[i] = (const float*)d_in[i];
    p.out = (float*)d_out; p.ws = (unsigned char*)d_ws;
#ifndef NPH_RUN
#define NPH_RUN (1 + 10 * DEPTH)
#endif
    const int NPH = NPH_RUN;
#if ONE_LAUNCH
    p.ph_lo = 0; p.ph_hi = NPH;
    void* args[] = {&p};
    hipError_t e = hipLaunchCooperativeKernel((const void*)fwd_megakernel, dim3(grid), dim3(512), args, LDS_BYTES, stream);
    if (e != hipSuccess) fprintf(stderr, "cooperative launch failed: %s (grid %d)\n", hipGetErrorString(e), grid);
#else
    for (int ph = 0; ph < NPH; ++ph) { p.ph_lo = ph; p.ph_hi = ph + 1; hipLaunchKernelGGL(fwd_megakernel, dim3(grid), dim3(512), LDS_BYTES, stream, p); }
#endif
}
```
